# Optimizing an MI355X kernel written in HIP

```python
import jax, jax.numpy as jnp
from jax import lax
import numpy as np

D_MODEL = 1024
BATCH = 2
SEQ = 8192
DEPTH = 1

D_MIX = D_MODEL
D_A = D_MIX // 2
D_B = D_MIX - D_A
N_HEADS_A = 8
HEAD_DIM_A = D_A // N_HEADS_A
N_GROUPS_B = 8
GROUP_DIM_B = D_B // N_GROUPS_B
CHUNK = 128
CONV_WIDTH = 31
D_IN = 2 * D_A + 2 * D_B
D_FF = -(-8 * D_MODEL // (3 * 256)) * 256
N_MOD = 6
EPS = 1e-6

kernel_name = "hybrid_sgu_conformer_conv_adaln_block"


def rmsnorm(x, g):
    xf = x.astype(jnp.float32)
    y = xf * lax.rsqrt(jnp.mean(xf * xf, axis=-1, keepdims=True) + EPS)
    return (y * g.astype(jnp.float32)).astype(x.dtype)


def layernorm(x, g, b):
    xf = x.astype(jnp.float32)
    mu = jnp.mean(xf, axis=-1, keepdims=True)
    xc = xf - mu
    var = jnp.mean(xc * xc, axis=-1, keepdims=True)
    y = xc * lax.rsqrt(var + EPS) * g.astype(jnp.float32) + b.astype(jnp.float32)
    return y.astype(x.dtype)


def modulate(h, shift, scale):
    return h * (1 + scale[:, None, :]) + shift[:, None, :]


def spatial_gating_mixer(u, v, ln_g, ln_b, w_s, b_s):
    B, S, _ = v.shape
    v = layernorm(v, ln_g, ln_b)
    v = v.reshape(B, S // CHUNK, CHUNK, N_HEADS_A, HEAD_DIM_A)
    causal = jnp.tril(jnp.ones((CHUNK, CHUNK), dtype=bool))
    w = jnp.where(causal[None], w_s, jnp.zeros_like(w_s)).astype(v.dtype)
    mixed = jnp.einsum('hts,bcshd->bcthd', w, v) + b_s.T.astype(v.dtype)[None, None, :, :, None]
    return u * mixed.reshape(B, S, D_A)


def conformer_conv_mixer(val, gate, conv_w, conv_b, gn_g, gn_b):
    B, S, _ = val.shape
    y = val * jax.nn.sigmoid(gate)
    y = lax.conv_general_dilated(
        y, conv_w[:, None, :].astype(y.dtype), window_strides=(1,),
        padding=[(CONV_WIDTH - 1, 0)],
        dimension_numbers=('NWC', 'WIO', 'NWC'),
        feature_group_count=D_B) + conv_b.astype(y.dtype)
    y = y.reshape(B, S, N_GROUPS_B, GROUP_DIM_B)
    y = layernorm(y, gn_g.reshape(N_GROUPS_B, GROUP_DIM_B), gn_b.reshape(N_GROUPS_B, GROUP_DIM_B))
    return jax.nn.silu(y.reshape(B, S, D_B))


def setup_inputs(seed: int = 0) -> dict:
    key = jax.random.key(seed)
    ks = jax.random.split(key, 24)
    f32 = jnp.float32
    nrm = lambda k, shape, s: jax.random.normal(k, shape, f32) * s
    L = DEPTH
    return {
        "x": jax.random.normal(ks[0], (BATCH, SEQ, D_MODEL), f32),
        "c": jax.random.normal(ks[1], (BATCH, D_MODEL), f32),
        "ada_w": nrm(ks[2], (L, D_MODEL, N_MOD * D_MODEL), D_MODEL ** -0.5),
        "ada_b": nrm(ks[3], (L, N_MOD * D_MODEL), 0.02),
        "norm1_g": 1.0 + nrm(ks[4], (L, D_MODEL), 0.05),
        "w_in": nrm(ks[5], (L, D_MODEL, D_IN), D_MODEL ** -0.5),
        "b_in": nrm(ks[6], (L, D_IN), 0.02),
        "a_ln_g": 1.0 + nrm(ks[7], (L, D_A), 0.05),
        "a_ln_b": nrm(ks[8], (L, D_A), 0.02),
        "a_spatial_w": nrm(ks[9], (L, N_HEADS_A, CHUNK, CHUNK), CHUNK ** -0.5),
        "a_spatial_b": 1.0 + nrm(ks[10], (L, N_HEADS_A, CHUNK), 0.1),
        "b_conv_w": nrm(ks[11], (L, CONV_WIDTH, D_B), CONV_WIDTH ** -0.5),
        "b_conv_b": nrm(ks[12], (L, D_B), 0.02),
        "b_gn_g": 1.0 + nrm(ks[13], (L, D_B), 0.05),
        "b_gn_b": nrm(ks[14], (L, D_B), 0.02),
        "out_norm_a_g": 1.0 + nrm(ks[15], (L, D_A), 0.05),
        "out_norm_b_g": 1.0 + nrm(ks[16], (L, D_B), 0.05),
        "w_out": nrm(ks[17], (L, D_MIX, D_MODEL), D_MIX ** -0.5),
        "norm2_g": 1.0 + nrm(ks[18], (L, D_MODEL), 0.05),
        "w_ffn_in": nrm(ks[19], (L, D_MODEL, 2 * D_FF), D_MODEL ** -0.5),
        "w_ffn_out": nrm(ks[20], (L, D_FF, D_MODEL), D_FF ** -0.5),
        "ada_f_w": nrm(ks[21], (D_MODEL, 2 * D_MODEL), D_MODEL ** -0.5),
        "ada_f_b": nrm(ks[22], (2 * D_MODEL,), 0.02),
        "norm_f_g": 1.0 + nrm(ks[23], (D_MODEL,), 0.05),
    }


def reference(x, c, ada_w, ada_b, norm1_g, w_in, b_in, a_ln_g, a_ln_b, a_spatial_w,
              a_spatial_b, b_conv_w, b_conv_b, b_gn_g, b_gn_b, out_norm_a_g, out_norm_b_g,
              w_out, norm2_g, w_ffn_in, w_ffn_out, ada_f_w, ada_f_b, norm_f_g):
    c_act = jax.nn.silu(c)
    for i in range(DEPTH):
        cond = c_act @ ada_w[i] + ada_b[i]
        shift1, scale1, gate1, shift2, scale2, gate2 = jnp.split(cond, N_MOD, axis=-1)

        h = modulate(rmsnorm(x, norm1_g[i]), shift1, scale1)
        z = h @ w_in[i] + b_in[i]
        u, v, val, gate = jnp.split(z, [D_A, 2 * D_A, 2 * D_A + D_B], axis=-1)
        y_a = spatial_gating_mixer(jax.nn.gelu(u, approximate=False),
                                   jax.nn.gelu(v, approximate=False),
                                   a_ln_g[i], a_ln_b[i], a_spatial_w[i], a_spatial_b[i])
        y_b = conformer_conv_mixer(val, gate, b_conv_w[i], b_conv_b[i], b_gn_g[i], b_gn_b[i])
        y = jnp.concatenate([rmsnorm(y_a, out_norm_a_g[i]), rmsnorm(y_b, out_norm_b_g[i])], axis=-1)
        x = x + gate1[:, None, :] * (y @ w_out[i])

        h2 = modulate(rmsnorm(x, norm2_g[i]), shift2, scale2)
        g_ff, up_ff = jnp.split(h2 @ w_ffn_in[i], 2, axis=-1)
        x = x + gate2[:, None, :] * ((jax.nn.silu(g_ff) * up_ff) @ w_ffn_out[i])

    shift_f, scale_f = jnp.split(c_act @ ada_f_w + ada_f_b, 2, axis=-1)
    return modulate(rmsnorm(x, norm_f_g), shift_f, scale_f)
```

```cpp
#define MK_N_LAUNCHES 1
#include <hip/hip_runtime.h>
#include <hip/hip_cooperative_groups.h>
#include <cstdio>
#include <cstdint>
namespace cg = cooperative_groups;
namespace pg8 {
#define PG8_LAS __attribute__((address_space(3)))
typedef unsigned short bf16_t;
typedef short bf16x8 __attribute__((ext_vector_type(8)));
typedef float f32x4 __attribute__((ext_vector_type(4)));
typedef unsigned u32x4 __attribute__((ext_vector_type(4)));
constexpr int BM = 256, BK = 64, HALF = 128, HTB = HALF * BK * 2  , STAGE_BYTES = 8 * HTB, NXCD = 8, WGM = 8;

__host__ __device__ __forceinline__ int lds_byte(int r, int c) { const int st = (r >> 4) * 2 + (c >> 5), rr = r & 15, cc = c & 31, ob = rr * 64 + cc * 2; return st * 1024 + (ob ^ (((ob >> 9) & 1) << 5)); }
__host__ __device__ __forceinline__ void stage_rc(int b, int& R, int& C) { const int st = b / 1024, sb = b % 1024, swz = sb ^ (((sb >> 9) & 1) << 5); R = (st >> 1) * 16 + swz / 64; C = (st & 1) * 32 + (swz % 64) / 2; }
__host__ __device__ __forceinline__ int perm32(int rho) { const int n = rho >> 4, i = rho & 15; return 8 * (i >> 2) + 4 * n + (i & 3); }

struct Unit { int pm, pn; };
struct Gemm { const bf16_t* A; const bf16_t* Bt; int M, N, K; size_t bBatch; };

struct StaticOrder {
    int nM, nN, nwg, G, c;
    __host__ __device__ void init(int M, int N, int G_, int c_) { nM = M / BM; nN = N / BM; nwg = nM * nN; G = G_; c = c_; }
    __host__ __device__ bool next(int i, Unit& u) const {
        const long L = (long)i * G + c; if (L >= nwg) return false;
        int wgid = (int)L; { const int q = nwg / NXCD, r = nwg % NXCD, xcd = wgid % NXCD, off = wgid / NXCD; wgid = (xcd < r ? xcd * (q + 1) : r * (q + 1) + (xcd - r) * q) + off; }
        const int nig = WGM * nN, gid = wgid / nig, fm = gid * WGM, gsz = (nM - fm) < WGM ? (nM - fm) : WGM;
        u.pm = fm + ((wgid % nig) % gsz); u.pn = (wgid % nig) / gsz; return true;
    }
    __device__ __forceinline__ void a_ready(const Unit&) const {}
    __device__ __forceinline__ void done(const Unit&) const {}
};

__device__ __forceinline__ unsigned cvt_pk_bf16(float lo, float hi) { unsigned r; asm volatile("v_cvt_pk_bf16_f32 %0, %1, %2" : "=v"(r) : "v"(lo), "v"(hi)); return r; }
typedef float f32x2 __attribute__((ext_vector_type(2)));
__device__ __forceinline__ f32x2 gelu_pk(f32x2 v) {
    const f32x2 av = __builtin_elementwise_abs(v), d = av * 0.2316418882f + 1.0f;
    f32x2 t; t.x = __builtin_amdgcn_rcpf(d.x); t.y = __builtin_amdgcn_rcpf(d.y);
    f32x2 q = t * 0.5307027145f + (-0.7265760135f); q = q * t + 0.7107068705f; q = q * t + (-0.142248368f); q = q * t + 0.127414796f; q = q * t;
    const f32x2 s = (v * v) * (-0.72134752044f);
    f32x2 e; e.x = __builtin_amdgcn_exp2f(s.x); e.y = __builtin_amdgcn_exp2f(s.y);
    const f32x2 m = v * (q * e), r = v - m;
    f32x2 o; o.x = v.x < 0.f ? m.x : r.x; o.y = v.y < 0.f ? m.y : r.y; return o;
}

__device__ __forceinline__ float sigm(float x) { return __builtin_amdgcn_rcpf(1.0f + __expf(-x)); }
__device__ __forceinline__ f32x4 sigm4(f32x4 x) { return (f32x4){sigm(x[0]), sigm(x[1]), sigm(x[2]), sigm(x[3])}; }
__device__ __forceinline__ u32x4 pack8(f32x4 v0, f32x4 v1) { u32x4 w; w.x = cvt_pk_bf16(v0[0], v0[1]); w.y = cvt_pk_bf16(v0[2], v0[3]); w.z = cvt_pk_bf16(v1[0], v1[1]); w.w = cvt_pk_bf16(v1[2], v1[3]); return w; }

struct EpiP1 {
    static constexpr bool PERM = true, AFTER_DRAIN = false;
    bf16_t* UV; bf16_t* Gb; const float* bias;
    __device__ __forceinline__ void operator()(const f32x4 (&acc)[2][2][4][2], const Unit& u, int wr, int wc, int fr, int fq) const {
        const int row0 = u.pm * BM + wr * 64 + fr;
        const int bcol0 = u.pn * BM + wc * 32 + 8 * fq;
        f32x4 bv[2][2];
#pragma unroll
        for (int bj = 0; bj < 2; ++bj)
#pragma unroll
            for (int n = 0; n < 2; ++n) bv[bj][n] = *(const f32x4*)(bias + bcol0 + bj * HALF + 4 * n);
        if (u.pn < 4) {
#pragma unroll
            for (int ai = 0; ai < 2; ++ai)
#pragma unroll
                for (int m = 0; m < 4; ++m) { bf16_t* rowp = UV + (size_t)(row0 + ai * HALF + m * 16) * 1024 + bcol0;
#pragma unroll
                    for (int bj = 0; bj < 2; ++bj) { f32x4 v0 = acc[ai][bj][m][0] + bv[bj][0], v1 = acc[ai][bj][m][1] + bv[bj][1];
                        f32x2 a = gelu_pk((f32x2){v0[0], v0[1]}), b = gelu_pk((f32x2){v0[2], v0[3]}), c = gelu_pk((f32x2){v1[0], v1[1]}), d = gelu_pk((f32x2){v1[2], v1[3]});
                        v0 = (f32x4){a.x, a.y, b.x, b.y}; v1 = (f32x4){c.x, c.y, d.x, d.y};
                        *(u32x4*)(rowp + bj * HALF) = pack8(v0, v1); } }
        } else {
            const int col0 = (u.pn - 4) * HALF + wc * 32 + 8 * fq;
#pragma unroll
            for (int ai = 0; ai < 2; ++ai)
#pragma unroll
                for (int m = 0; m < 4; ++m) { bf16_t* rowp = Gb + (size_t)(row0 + ai * HALF + m * 16) * 512 + col0;
                    const f32x4 v0 = acc[ai][0][m][0] + bv[0][0], v1 = acc[ai][0][m][1] + bv[0][1], g0 = acc[ai][1][m][0] + bv[1][0], g1 = acc[ai][1][m][1] + bv[1][1];
                    *(u32x4*)rowp = pack8(v0 * sigm4(g0), v1 * sigm4(g1)); }
        }
    }
};

template <bool WITH_XB> struct EpiRes {
    static constexpr bool PERM = false, AFTER_DRAIN = false;
    const float* xi; float* xo; const float* gate;
    bf16_t* xb; float* ssq;
    __device__ __forceinline__ void operator()(const f32x4 (&acc)[2][2][4][2], const Unit& u, int wr, int wc, int fr, int fq) const {
        typedef unsigned u32x2v __attribute__((ext_vector_type(2)));
        const int col0 = u.pn * BM + wc * 32 + 4 * fq;
        const float* gp = gate + (u.pm >= 32 ? 8192 : 0) + col0;
        f32x4 gv[2][2];
#pragma unroll
        for (int bj = 0; bj < 2; ++bj)
#pragma unroll
            for (int n = 0; n < 2; ++n) gv[bj][n] = *(const f32x4*)(gp + bj * HALF + n * 16);
#pragma unroll
        for (int ai = 0; ai < 2; ++ai)
#pragma unroll
            for (int m = 0; m < 4; ++m) { const int r = u.pm * BM + ai * HALF + wr * 64 + m * 16 + fr; const size_t off = (size_t)r * 1024 + col0; float ss = 0.f;
#pragma unroll
                for (int bj = 0; bj < 2; ++bj)
#pragma unroll
                    for (int n = 0; n < 2; ++n) { const f32x4 xs = *(const f32x4*)(xi + off + bj * HALF + n * 16); const f32x4 o = xs + gv[bj][n] * acc[ai][bj][m][n];
                        *(f32x4*)(xo + off + bj * HALF + n * 16) = o;
                        if (WITH_XB) { ss += (o[0] * o[0] + o[1] * o[1]) + (o[2] * o[2] + o[3] * o[3]); u32x2v w; w.x = cvt_pk_bf16(o[0], o[1]); w.y = cvt_pk_bf16(o[2], o[3]); *(u32x2v*)(xb + off + bj * HALF + n * 16) = w; } }
                if (WITH_XB) { ss += __shfl_xor(ss, 16); ss += __shfl_xor(ss, 32); if (fq == 0) ssq[(size_t)r * 16 + u.pn * 4 + wc] = ss; }
                if (m & 1) asm volatile("" ::: "memory"); }
    }
};

struct EpiP4 {
    static constexpr bool PERM = true, AFTER_DRAIN = false;
    bf16_t* H; const float* bias; const float* ssq;
    __device__ __forceinline__ void operator()(const f32x4 (&acc)[2][2][4][2], const Unit& u, int wr, int wc, int fr, int fq) const {
        const int row0 = u.pm * BM + wr * 64 + fr;
        const int bcol0 = u.pn * BM + wc * 32 + 8 * fq;
        const float* bp = bias + (u.pm >= 32 ? 5632 : 0) + bcol0;
        f32x4 bv[2][2];
#pragma unroll
        for (int bj = 0; bj < 2; ++bj)
#pragma unroll
            for (int n = 0; n < 2; ++n) bv[bj][n] = *(const f32x4*)(bp + bj * HALF + 4 * n);
        const int col0 = u.pn * HALF + wc * 32 + 8 * fq;
#pragma unroll
        for (int ai = 0; ai < 2; ++ai)
#pragma unroll
            for (int m = 0; m < 4; ++m) { const int r = row0 + ai * HALF + m * 16;
                const f32x4* sp = (const f32x4*)(ssq + (size_t)r * 16); const f32x4 s0 = sp[0], s1 = sp[1], s2 = sp[2], s3 = sp[3];
                const float st = (((s0[0] + s0[1]) + (s0[2] + s0[3])) + ((s1[0] + s1[1]) + (s1[2] + s1[3]))) + (((s2[0] + s2[1]) + (s2[2] + s2[3])) + ((s3[0] + s3[1]) + (s3[2] + s3[3])));
                const float rstd = 1.0f / sqrtf(st * (1.0f / 1024.0f) + 1e-6f);
                const f32x4 g0 = acc[ai][0][m][0] * rstd + bv[0][0], g1 = acc[ai][0][m][1] * rstd + bv[0][1], u0 = acc[ai][1][m][0] * rstd + bv[1][0], u1 = acc[ai][1][m][1] * rstd + bv[1][1];
                *(u32x4*)(H + (size_t)r * 2816 + col0) = pack8(g0 * sigm4(g0) * u0, g1 * sigm4(g1) * u1); }
    }
};
template <class Epi, class Sched, bool ALIGN_EPI = false, bool SP2 = false>
__device__ __forceinline__ void gemm_phase(PG8_LAS unsigned char* lds, const Gemm g, const Sched& S, const Epi& E) {
    const int tid = threadIdx.x, wid = __builtin_amdgcn_readfirstlane(tid >> 6), lane = tid & 63, wr = wid >> 2, wc = wid & 3, fr = lane & 15, fq = lane >> 4;
    const int K = g.K, nt = K / BK;
    unsigned voffA[2], voffB[2];
#pragma unroll
    for (int i = 0; i < 2; ++i) { int R, C; stage_rc(tid * 16 + i * 8192, R, C); const int Rb = Epi::PERM ? ((R & ~31) + perm32(R & 31)) : R;
        voffA[i] = (unsigned)(R * K + C) * 2u; voffB[i] = (unsigned)(Rb * K + C) * 2u; }
    const size_t kstep = (size_t)(BK * 2);
    const size_t hstep = (size_t)HALF * K * 2;
    const size_t tstep = 2 * hstep;
    const unsigned ldsw = (unsigned)wid * 1024u;
    const int aoff = lds_byte(wr * 64 + fr, fq * 8), boff = lds_byte(wc * 32 + fr, fq * 8);
#define PG8_SA(b, h) (((b) * 2 + (h)) * HTB)
#define PG8_SB(b, h) ((4 + (b) * 2 + (h)) * HTB)
#define PG8_STAGE(bufoff, gbase, voff) do { _Pragma("unroll") for (int _i = 0; _i < 2; ++_i) \
        __builtin_amdgcn_global_load_lds((const unsigned*)((const char*)(gbase) + (voff)[_i]), (PG8_LAS unsigned*)(lds + (bufoff) + ldsw + _i * 8192), 16, 0, 0); } while (0)
#define PG8_LDA(dst, b, h) do { _Pragma("unroll") for (int m = 0; m < 4; ++m) _Pragma("unroll") for (int k = 0; k < 2; ++k) dst[m][k] = *(const PG8_LAS bf16x8*)(lds + PG8_SA(b, h) + aoff + m * 2048 + k * 1024); } while (0)
#define PG8_LDB(dst, b, h) do { _Pragma("unroll") for (int n = 0; n < 2; ++n) _Pragma("unroll") for (int k = 0; k < 2; ++k) dst[n][k] = *(const PG8_LAS bf16x8*)(lds + PG8_SB(b, h) + boff + n * 2048 + k * 1024); } while (0)
#define PG8_MMA(ai, bj, At, Bt) do { __builtin_amdgcn_s_setprio(1); _Pragma("unroll") for (int m = 0; m < 4; ++m) _Pragma("unroll") for (int n = 0; n < 2; ++n) _Pragma("unroll") for (int k = 0; k < 2; ++k) \
        acc[ai][bj][m][n] = __builtin_amdgcn_mfma_f32_16x16x32_bf16(Bt[n][k], At[m][k], acc[ai][bj][m][n], 0, 0, 0); __builtin_amdgcn_s_setprio(0); } while (0)
#define PG8_WAIT_V(n) asm volatile("s_waitcnt vmcnt(" #n ")" ::: "memory")
#define PG8_WAIT_L(n) asm volatile("s_waitcnt lgkmcnt(" #n ")" ::: "memory")
#define PG8_BAR __builtin_amdgcn_s_barrier()
#define PG8_SCHED __builtin_amdgcn_sched_barrier(0)
    Unit cur, nxt; int ui = 0;
    if (!S.next(0, cur)) return;
    f32x4 acc[2][2][4][2];
#pragma unroll
    for (int a = 0; a < 2; ++a)
#pragma unroll
        for (int b = 0; b < 2; ++b)
#pragma unroll
            for (int m = 0; m < 4; ++m)
#pragma unroll
                for (int n = 0; n < 2; ++n) acc[a][b][m][n] = (f32x4){0.f, 0.f, 0.f, 0.f};
    bf16x8 At[4][2], B0[2][2], B1[2][2];
    const char* cA = (const char*)g.A + (size_t)cur.pm * tstep; const char* cB = (const char*)g.Bt + (size_t)cur.pn * tstep + (cur.pm >= 32 ? g.bBatch : (size_t)0);
    S.a_ready(cur);
    if constexpr (SP2) {
        PG8_STAGE(PG8_SB(0, 0), cB, voffB); PG8_STAGE(PG8_SB(0, 1), cB + hstep, voffB); PG8_STAGE(PG8_SA(0, 0), cA, voffA); PG8_STAGE(PG8_SA(0, 1), cA + hstep, voffA);
        if (wr == 1) PG8_BAR;
        PG8_WAIT_V(2); PG8_BAR;
        PG8_STAGE(PG8_SB(1, 0), cB + kstep, voffB); PG8_STAGE(PG8_SA(1, 0), cA + kstep, voffA); PG8_STAGE(PG8_SB(1, 1), cB + hstep + kstep, voffB);
        PG8_WAIT_V(6); PG8_BAR;
    } else {
        PG8_STAGE(PG8_SB(0, 0), cB, voffB); PG8_STAGE(PG8_SA(0, 0), cA, voffA); PG8_STAGE(PG8_SB(0, 1), cB + hstep, voffB); PG8_STAGE(PG8_SA(0, 1), cA + hstep, voffA);
        if (wr == 1) PG8_BAR;
        PG8_WAIT_V(4); PG8_BAR;
        PG8_STAGE(PG8_SB(1, 0), cB + kstep, voffB); PG8_STAGE(PG8_SA(1, 0), cA + kstep, voffA); PG8_STAGE(PG8_SB(1, 1), cB + hstep + kstep, voffB);
        PG8_WAIT_V(6); PG8_BAR;
    }
    for (;;) {
        const bool has_next = S.next(ui + 1, nxt);
        const char* nA = has_next ? (const char*)g.A + (size_t)nxt.pm * tstep : cA; const char* nB = has_next ? (const char*)g.Bt + (size_t)nxt.pn * tstep + (nxt.pm >= 32 ? g.bBatch : (size_t)0) : cB;
        for (int t = 0; t < nt; t += 2) {
            const bool last = (t == nt - 2);
            const char* a1 = cA + (size_t)(t + 1) * kstep;
            const char* a2 = last ? nA : cA + (size_t)(t + 2) * kstep; const char* b2 = last ? nB : cB + (size_t)(t + 2) * kstep;
            const char* a3 = a2 + kstep; const char* b3 = b2 + kstep;
            if (last && has_next) S.a_ready(nxt);
            if constexpr (SP2) {
            PG8_LDB(B0, 0, 0); PG8_LDB(B1, 0, 1); PG8_SCHED; PG8_LDA(At, 0, 0); PG8_STAGE(PG8_SA(1, 1), a1 + hstep, voffA);
            PG8_WAIT_V(8); PG8_WAIT_L(0); PG8_BAR; PG8_MMA(0, 0, At, B0); PG8_MMA(0, 1, At, B1); PG8_BAR; PG8_SCHED;
            PG8_LDA(At, 0, 1); PG8_STAGE(PG8_SB(0, 0), b2, voffB); PG8_STAGE(PG8_SB(0, 1), b2 + hstep, voffB); PG8_STAGE(PG8_SA(0, 0), a2, voffA);
            PG8_WAIT_V(8); PG8_WAIT_L(0); PG8_BAR; PG8_MMA(1, 0, At, B0); PG8_MMA(1, 1, At, B1); PG8_BAR; PG8_SCHED;
            PG8_LDB(B0, 1, 0); PG8_LDB(B1, 1, 1); PG8_SCHED; PG8_LDA(At, 1, 0); PG8_STAGE(PG8_SA(0, 1), a2 + hstep, voffA);
            PG8_WAIT_V(8); PG8_WAIT_L(0); PG8_BAR; PG8_MMA(0, 0, At, B0); PG8_MMA(0, 1, At, B1); PG8_BAR; PG8_SCHED;
            PG8_LDA(At, 1, 1); PG8_STAGE(PG8_SB(1, 0), b3, voffB); PG8_STAGE(PG8_SB(1, 1), b3 + hstep, voffB); PG8_STAGE(PG8_SA(1, 0), a3, voffA);
            PG8_WAIT_V(8); PG8_WAIT_L(0); PG8_BAR; PG8_MMA(1, 0, At, B0); PG8_MMA(1, 1, At, B1); PG8_BAR; PG8_SCHED;
            } else {
            PG8_LDB(B0, 0, 0); PG8_SCHED; PG8_LDA(At, 0, 0); PG8_STAGE(PG8_SA(1, 1), a1 + hstep, voffA);
            PG8_WAIT_L(8); PG8_BAR; PG8_WAIT_L(0); PG8_MMA(0, 0, At, B0); PG8_BAR; PG8_SCHED;
            PG8_LDB(B1, 0, 1); PG8_STAGE(PG8_SB(0, 0), b2, voffB);
            PG8_BAR; PG8_WAIT_L(0); PG8_MMA(0, 1, At, B1); PG8_BAR;
            PG8_LDA(At, 0, 1); PG8_STAGE(PG8_SA(0, 0), a2, voffA);
            PG8_BAR; PG8_WAIT_L(0); PG8_MMA(1, 0, At, B0); PG8_BAR; PG8_SCHED;
            PG8_STAGE(PG8_SB(0, 1), b2 + hstep, voffB);
            PG8_WAIT_V(6); PG8_BAR; PG8_MMA(1, 1, At, B1); PG8_BAR;
            PG8_LDB(B0, 1, 0); PG8_SCHED; PG8_LDA(At, 1, 0); PG8_STAGE(PG8_SA(0, 1), a2 + hstep, voffA);
            PG8_WAIT_L(8); PG8_BAR; PG8_WAIT_L(0); PG8_MMA(0, 0, At, B0); PG8_BAR; PG8_SCHED;
            PG8_LDB(B1, 1, 1); PG8_STAGE(PG8_SB(1, 0), b3, voffB);
            PG8_BAR; PG8_WAIT_L(0); PG8_MMA(0, 1, At, B1); PG8_BAR;
            PG8_LDA(At, 1, 1); PG8_STAGE(PG8_SA(1, 0), a3, voffA);
            PG8_BAR; PG8_WAIT_L(0); PG8_MMA(1, 0, At, B0); PG8_BAR; PG8_SCHED;
            PG8_STAGE(PG8_SB(1, 1), b3 + hstep, voffB);
            PG8_WAIT_V(6); PG8_BAR; PG8_MMA(1, 1, At, B1); PG8_BAR;
            }
        }
        if constexpr (ALIGN_EPI) { if (wr == 0) PG8_BAR; }
        if constexpr (!Epi::AFTER_DRAIN) { E(acc, cur, wr, wc, fr, fq); S.done(cur); }
        if (!has_next) break;
#pragma unroll
        for (int a = 0; a < 2; ++a)
#pragma unroll
            for (int b = 0; b < 2; ++b)
#pragma unroll
                for (int m = 0; m < 4; ++m)
#pragma unroll
                    for (int n = 0; n < 2; ++n) acc[a][b][m][n] = (f32x4){0.f, 0.f, 0.f, 0.f};
        cur = nxt; cA = nA; cB = nB; ++ui;
        if constexpr (ALIGN_EPI) { if (wr == 1) PG8_BAR; }
    }
    PG8_WAIT_V(0);
    if constexpr (!ALIGN_EPI) { if (wr == 0) PG8_BAR; }
    PG8_BAR;
    if constexpr (Epi::AFTER_DRAIN) { E.fused(acc, cur, wr, wc, fr, fq, lds, wid, lane); S.done(cur); }
#undef PG8_SA
#undef PG8_SB
#undef PG8_STAGE
#undef PG8_LDA
#undef PG8_LDB
#undef PG8_MMA
#undef PG8_WAIT_V
#undef PG8_WAIT_L
#undef PG8_BAR
#undef PG8_SCHED
}
}

#ifndef MK_N_LAUNCHES
#define MK_N_LAUNCHES 1
#endif
constexpr int NWAVES = 8, NTHR = NWAVES * 64;
constexpr int SEQ = 8192, D = 1024, M = 2 * SEQ, DIN = 2048, DFF = 2816, NFF = 2 * DFF;
constexpr float EPS = 1e-6f;
constexpr int NPH = 8;

constexpr size_t MiB = 1u << 20;
constexpr size_t WS_COND = 1 * MiB;
constexpr size_t WS_BIAS1 = 1 * MiB + 65536;
constexpr size_t WS_BIAS2 = 1 * MiB + 131072;
constexpr size_t WS_P2PART = 2 * MiB;
constexpr size_t WS_SSQ1 = 3 * MiB;
constexpr size_t WS_WSP = 4 * MiB;
constexpr size_t WS_WIN = 6 * MiB;
constexpr size_t WS_WOUT = 10 * MiB;
constexpr size_t WS_WF2 = 12 * MiB;
constexpr size_t WS_WF1 = 18 * MiB;
constexpr size_t WS_XN = 40 * MiB;
constexpr size_t WS_UV = 72 * MiB;
constexpr size_t WS_G = 104 * MiB;
constexpr size_t WS_Y = 120 * MiB;
constexpr size_t WS_H = 152 * MiB;
constexpr size_t WS_END = 240 * MiB;

constexpr int LDS_BYTES = 155648;
constexpr int TROW = 1040;
constexpr int TILE_BYTES = 128 * TROW;

#define LAS __attribute__((address_space(3)))
typedef unsigned short bf16;
typedef unsigned v4u __attribute__((ext_vector_type(4)));
typedef unsigned v2u __attribute__((ext_vector_type(2)));
typedef float f32x4 __attribute__((ext_vector_type(4)));
typedef float f32x2 __attribute__((ext_vector_type(2)));
typedef short bf16x8 __attribute__((ext_vector_type(8)));
#define LDS_WAIT() asm volatile("s_waitcnt lgkmcnt(0)" ::: "memory")

__device__ __forceinline__ unsigned pk2(float lo, float hi) { return pg8::cvt_pk_bf16(lo, hi); }
__device__ __forceinline__ float bflo(unsigned w) { return __uint_as_float(w << 16); }
__device__ __forceinline__ float bfhi(unsigned w) { return __uint_as_float(w & 0xffff0000u); }
__device__ __forceinline__ void unpack8(v4u w, float (&f)[8]) { f[0] = bflo(w.x); f[1] = bfhi(w.x); f[2] = bflo(w.y); f[3] = bfhi(w.y); f[4] = bflo(w.z); f[5] = bfhi(w.z); f[6] = bflo(w.w); f[7] = bfhi(w.w); }
__device__ __forceinline__ v4u pack8f(const float (&f)[8]) { v4u w; w.x = pk2(f[0], f[1]); w.y = pk2(f[2], f[3]); w.z = pk2(f[4], f[5]); w.w = pk2(f[6], f[7]); return w; }
__device__ __forceinline__ float wave_sum(float v) {
#pragma unroll
    for (int o = 1; o < 64; o <<= 1) v += __shfl_xor(v, o);
    return v;
}
__device__ __forceinline__ float half_sum(float v) {
#pragma unroll
    for (int o = 1; o < 32; o <<= 1) v += __shfl_xor(v, o);
    return v;
}
__device__ __forceinline__ float siluf(float x) { return x * __builtin_amdgcn_rcpf(1.0f + __expf(-x)); }

struct Frame {
    LAS unsigned char* lds;
    int tid, lane, wave, vcu, G;
    const float* in[24]; float* out; unsigned char* ws;
};
enum { I_X = 0, I_C, I_ADAW, I_ADAB, I_N1G, I_WIN, I_BIN, I_ALNG, I_ALNB, I_ASW, I_ASB, I_CW, I_CB, I_GNG, I_GNB, I_ONA, I_ONB, I_WOUT, I_N2G, I_WF1, I_WF2, I_ADAFW, I_ADAFB, I_NFG };

__device__ __forceinline__ int map_in(int c) { if (c < 1024) return c; if (c < 1536) { const int j = c - 1024; return 1024 + 256 * (j >> 7) + (j & 127); } const int j = c - 1536; return 1024 + 256 * (j >> 7) + 128 + (j & 127); }
__device__ __forceinline__ int map_ff(int c) { if (c < DFF) return 256 * (c >> 7) + (c & 127); const int j = c - DFF; return 256 * (j >> 7) + 128 + (j & 127); }

__device__ __forceinline__ void transpose_item(const float* W, int K, int N, bf16* WT, int dst0, int k0, int n0, LAS float* scr, int lane) {
#pragma unroll 8
    for (int i = 0; i < 32; ++i) { const int kk = 2 * i + (lane >> 5); scr[kk * 33 + (lane & 31)] = W[(size_t)(k0 + kk) * N + n0 + (lane & 31)]; }
    LDS_WAIT(); asm volatile("" ::: "memory");
    const int c = lane & 7;
#pragma unroll
    for (int j = 0; j < 4; ++j) { const int n = (lane >> 3) + 8 * j; const LAS float* s = scr + (8 * c) * 33 + n;
        v4u o; o.x = pk2(s[0 * 33], s[1 * 33]); o.y = pk2(s[2 * 33], s[3 * 33]); o.z = pk2(s[4 * 33], s[5 * 33]); o.w = pk2(s[6 * 33], s[7 * 33]);
        *(v4u*)(WT + (size_t)(dst0 + n) * K + k0 + 8 * c) = o; }
    LDS_WAIT(); asm volatile("" ::: "memory");
}

__device__ __forceinline__ void p0_phase(Frame& F) {
    LAS float* sc = (LAS float*)F.lds; LAS float* red = (LAS float*)(F.lds + 8192);
    float* COND = (float*)(F.ws + WS_COND);
    for (int i = F.tid; i < 2048; i += NTHR) { const float v = F.in[I_C][i]; sc[i] = siluf(v); }
    __syncthreads();
    for (int cb = F.vcu; cb < 256; cb += F.G) {
        const float* W; const float* bias; int N, n0, cofs;
        if (cb < 192) { W = F.in[I_ADAW]; N = 6144; n0 = 32 * cb; bias = F.in[I_ADAB]; cofs = n0; } else { W = F.in[I_ADAFW]; N = 2048; n0 = 32 * (cb - 192); bias = F.in[I_ADAFB]; cofs = 6144 + n0; }
        const int col = F.lane & 31, par = F.lane >> 5;
        float a0 = 0.f, a1 = 0.f;
        const float* wp = W + (size_t)(128 * F.wave + par) * N + n0 + col;
#pragma unroll 16
        for (int i = 0; i < 64; ++i) { const float wv = wp[(size_t)(2 * i) * N]; const int k = 128 * F.wave + 2 * i + par; a0 += sc[k] * wv; a1 += sc[1024 + k] * wv; }
        a0 += __shfl_xor(a0, 32); a1 += __shfl_xor(a1, 32);
        if (F.lane < 32) { red[(F.wave * 2 + 0) * 32 + col] = a0; red[(F.wave * 2 + 1) * 32 + col] = a1; }
        __syncthreads();
        if (F.tid < 64) { const int b = F.tid >> 5, cc = F.tid & 31; float s = 0.f;
#pragma unroll
            for (int w = 0; w < 8; ++w) s += red[(w * 2 + b) * 32 + cc];
            COND[b * 8192 + cofs + cc] = s + bias[n0 + cc]; }
        __syncthreads();
    }
    LAS float* scr = (LAS float*)(F.lds + 16384 + F.wave * 8704);
    const int gw = F.vcu * NWAVES + F.wave, NGW = F.G * NWAVES;
    constexpr int I_IN = 16 * 64, I_OUT = 16 * 32, I_F2 = 44 * 32, NIT = I_IN + I_OUT + I_F2;
    for (int it = gw; it < NIT; it += NGW) {
        int r = it;
        if (r < I_IN) { const int kb = r / 64, nb = r % 64; transpose_item(F.in[I_WIN], 1024, DIN, (bf16*)(F.ws + WS_WIN), map_in(32 * nb), 64 * kb, 32 * nb, scr, F.lane); continue; } r -= I_IN;
        if (r < I_OUT) { const int kb = r / 32, nb = r % 32; transpose_item(F.in[I_WOUT], 1024, 1024, (bf16*)(F.ws + WS_WOUT), 32 * nb, 64 * kb, 32 * nb, scr, F.lane); continue; } r -= I_OUT;
        { const int kb = r / 32, nb = r % 32; transpose_item(F.in[I_WF2], DFF, 1024, (bf16*)(F.ws + WS_WF2), 32 * nb, 64 * kb, 32 * nb, scr, F.lane); }
    }
    const int gt = F.vcu * NTHR + F.tid, NT = F.G * NTHR;
    bf16* WSP = (bf16*)(F.ws + WS_WSP);
    for (int e = gt; e < 8 * 128 * 128; e += NT) { const int t = (e >> 7) & 127, s = e & 127; const float v = F.in[I_ASW][e]; WSP[e] = (bf16)(s <= t ? (pk2(v, 0.f) & 0xffffu) : 0u); }
    float* B1 = (float*)(F.ws + WS_BIAS1);
    for (int e = gt; e < DIN; e += NT) B1[map_in(e)] = F.in[I_BIN][e];
}

__device__ __forceinline__ void p0b_phase(Frame& F) {
    const float* COND = (const float*)(F.ws + WS_COND);
    const int gw = F.vcu * NWAVES + F.wave, NGW = F.G * NWAVES;
    bf16* XN = (bf16*)(F.ws + WS_XN);
    for (int rb = gw; rb < M / 8; rb += NGW) {
        const int b = (rb * 8) >= SEQ ? 1 : 0;
        f32x4 av[4], sv[4];
#pragma unroll
        for (int j = 0; j < 4; ++j) { const int col = 4 * F.lane + 256 * j; const f32x4 g = *(const f32x4*)(F.in[I_N1G] + col), sc = *(const f32x4*)(COND + b * 8192 + 1024 + col); av[j] = g * (sc + 1.0f); sv[j] = *(const f32x4*)(COND + b * 8192 + col); }
#pragma unroll 2
        for (int i = 0; i < 8; ++i) { const int row = rb * 8 + i; const f32x4* xr = (const f32x4*)(F.in[I_X] + (size_t)row * D) + F.lane;
            f32x4 v[4]; float s = 0.f;
#pragma unroll
            for (int j = 0; j < 4; ++j) { v[j] = xr[64 * j]; s += (v[j][0] * v[j][0] + v[j][1] * v[j][1]) + (v[j][2] * v[j][2] + v[j][3] * v[j][3]); }
            const float rstd = 1.0f / sqrtf(wave_sum(s) * (1.0f / D) + EPS);
            v2u* o8 = (v2u*)(XN + (size_t)row * D) + F.lane;
#pragma unroll
            for (int j = 0; j < 4; ++j) { const f32x4 o = v[j] * rstd * av[j] + sv[j]; v2u w; w.x = pk2(o[0], o[1]); w.y = pk2(o[2], o[3]); o8[64 * j] = w; } }
    }
    LAS float* scr = (LAS float*)(F.lds + F.wave * 8704);
    bf16* WF1 = (bf16*)(F.ws + WS_WF1); float* PART = (float*)(F.ws + WS_P2PART);
    const float* W = F.in[I_WF1];
    for (int it = gw; it < 16 * 176; it += NGW) {
        const int kb = it / 176, nb = it % 176, k0 = 64 * kb, n0 = 32 * nb, dst0 = map_ff(n0);
#pragma unroll 8
        for (int i = 0; i < 32; ++i) { const int kk = 2 * i + (F.lane >> 5); scr[kk * 33 + (F.lane & 31)] = W[(size_t)(k0 + kk) * NFF + n0 + (F.lane & 31)]; }
        LDS_WAIT(); asm volatile("" ::: "memory");
        { const int b = F.lane >> 5, n = F.lane & 31; const float* sh = COND + b * 8192 + 3072 + k0; float p = 0.f;
#pragma unroll 8
            for (int kk = 0; kk < 64; ++kk) p += sh[kk] * scr[kk * 33 + n];
            PART[(size_t)(kb * 2 + b) * NFF + dst0 + n] = p; }
        const int c = F.lane & 7;
#pragma unroll
        for (int b = 0; b < 2; ++b) {
            const f32x4 ga = *(const f32x4*)(F.in[I_N2G] + k0 + 8 * c), gb = *(const f32x4*)(F.in[I_N2G] + k0 + 8 * c + 4);
            const f32x4 sa = *(const f32x4*)(COND + b * 8192 + 4096 + k0 + 8 * c), sb = *(const f32x4*)(COND + b * 8192 + 4096 + k0 + 8 * c + 4);
            const f32x4 a0 = ga * (sa + 1.0f), a1 = gb * (sb + 1.0f);
#pragma unroll
            for (int j = 0; j < 4; ++j) { const int n = (F.lane >> 3) + 8 * j; const LAS float* s = scr + (8 * c) * 33 + n;
                v4u o; o.x = pk2(s[0 * 33] * a0[0], s[1 * 33] * a0[1]); o.y = pk2(s[2 * 33] * a0[2], s[3 * 33] * a0[3]); o.z = pk2(s[4 * 33] * a1[0], s[5 * 33] * a1[1]); o.w = pk2(s[6 * 33] * a1[2], s[7 * 33] * a1[3]);
                *(v4u*)(WF1 + ((size_t)b * NFF + dst0 + n) * 1024 + k0 + 8 * c) = o; }
        }
        LDS_WAIT(); asm volatile("" ::: "memory");
    }
}

__device__ __forceinline__ void mixer_tail(Frame& F, int r0, const float* gain, int coloff) {
    bf16* Y = (bf16*)(F.ws + WS_Y);
    const f32x4 g0 = *(const f32x4*)(gain + 8 * F.lane), g1 = *(const f32x4*)(gain + 8 * F.lane + 4);
#pragma unroll 4
    for (int i = 0; i < 16; ++i) { const int t = 16 * F.wave + i;
        const v4u w = *(const LAS v4u*)(F.lds + t * TROW + 16 * F.lane); float f[8]; unpack8(w, f);
        float s = 0.f;
#pragma unroll
        for (int j = 0; j < 8; ++j) s += f[j] * f[j];
        const float rstd = 1.0f / sqrtf(wave_sum(s) * (1.0f / 512.0f) + EPS);
        float o[8];
#pragma unroll
        for (int j = 0; j < 4; ++j) { o[j] = f[j] * rstd * g0[j]; o[4 + j] = f[4 + j] * rstd * g1[j]; }
        *(v4u*)(Y + (size_t)(r0 + t) * 1024 + coloff + 8 * F.lane) = pack8f(o); }
}

__device__ __forceinline__ int opaque_zero() { int z; asm volatile("s_mov_b32 %0, 0" : "=s"(z)); return z; }
__device__ __forceinline__ void mixer_a_unit(Frame& F, int ci) {
    const int r0 = 128 * ci; const int oz = opaque_zero();
    const bf16* UV = (const bf16*)(F.ws + WS_UV) + oz; const bf16* WSP = (const bf16*)(F.ws + WS_WSP) + oz;
    {
        const f32x4 lg0 = *(const f32x4*)(F.in[I_ALNG] + oz + 8 * F.lane), lg1 = *(const f32x4*)(F.in[I_ALNG] + oz + 8 * F.lane + 4);
        const f32x4 lb0 = *(const f32x4*)(F.in[I_ALNB] + oz + 8 * F.lane), lb1 = *(const f32x4*)(F.in[I_ALNB] + oz + 8 * F.lane + 4);
#pragma unroll 4
        for (int i = 0; i < 16; ++i) { const int s = 16 * F.wave + i;
            const v4u w = *(const v4u*)(UV + (size_t)(r0 + s) * 1024 + 512 + 8 * F.lane); float f[8]; unpack8(w, f);
            float sm = 0.f;
#pragma unroll
            for (int j = 0; j < 8; ++j) sm += f[j];
            const float mean = wave_sum(sm) * (1.0f / 512.0f); float q = 0.f;
#pragma unroll
            for (int j = 0; j < 8; ++j) { f[j] -= mean; q += f[j] * f[j]; }
            const float rstd = 1.0f / sqrtf(wave_sum(q) * (1.0f / 512.0f) + EPS);
            float o[8];
#pragma unroll
            for (int j = 0; j < 4; ++j) { o[j] = f[j] * rstd * lg0[j] + lb0[j]; o[4 + j] = f[4 + j] * rstd * lg1[j] + lb1[j]; }
            *(LAS v4u*)(F.lds + s * TROW + 16 * F.lane) = pack8f(o); }
    }
    __syncthreads();
    {
        const int h = F.wave, fr = F.lane & 15, q = F.lane >> 4;
        const float* bsp = F.in[I_ASB] + h * 128 + oz;
#pragma unroll 1
        for (int dt = 0; dt < 4; ++dt) {
            const int colb = 2 * (h * 64 + 16 * dt + fr);
            bf16x8 Yf[4];
#pragma unroll
            for (int st = 0; st < 4; ++st) { unsigned e[8];
#pragma unroll
                for (int j = 0; j < 8; ++j) e[j] = *(const LAS unsigned short*)(F.lds + (32 * st + 8 * q + j) * TROW + colb);
                v4u w; w.x = e[0] | (e[1] << 16); w.y = e[2] | (e[3] << 16); w.z = e[4] | (e[5] << 16); w.w = e[6] | (e[7] << 16);
                Yf[st] = __builtin_bit_cast(bf16x8, w); }
            LDS_WAIT(); asm volatile("" ::: "memory");
#pragma unroll 2
            for (int tt = 0; tt < 8; ++tt) {
                f32x4 acc = (f32x4){0.f, 0.f, 0.f, 0.f};
#pragma unroll
                for (int st = 0; st < 4; ++st) { const bf16x8 X = *(const bf16x8*)(WSP + ((size_t)(h * 128 + 16 * tt + fr) * 128 + 32 * st + 8 * q));
                    acc = __builtin_amdgcn_mfma_f32_16x16x32_bf16(X, Yf[st], acc, 0, 0, 0); }
#pragma unroll
                for (int v = 0; v < 4; ++v) { const int t = 16 * tt + 4 * q + v;
                    const float uu = bflo((unsigned)UV[(size_t)(r0 + t) * 1024 + h * 64 + 16 * dt + fr]);
                    const float y = uu * (acc[v] + bsp[t]);
                    *(LAS unsigned short*)(F.lds + t * TROW + colb) = (unsigned short)(pk2(y, 0.f) & 0xffffu); }
            }
        }
    }
    __syncthreads();
    mixer_tail(F, r0, F.in[I_ONA] + oz, 0);
    __syncthreads();
}

__device__ __forceinline__ void mixer_b_unit(Frame& F, int ci) {
    const int r0 = 128 * ci, bs_row = (ci >> 6) * SEQ; const int oz = opaque_zero();
    const bf16* Gb = (const bf16*)(F.ws + WS_G) + oz;
    {
        const int cq = F.wave & 3, th = F.wave >> 2, c0 = 128 * cq + 2 * F.lane + oz;
        f32x2 wr_[31];
#pragma unroll
        for (int j = 0; j < 31; ++j) wr_[j] = *(const f32x2*)(F.in[I_CW] + j * 512 + c0);
        const f32x2 cb = *(const f32x2*)(F.in[I_CB] + c0), gg = *(const f32x2*)(F.in[I_GNG] + c0), gb = *(const f32x2*)(F.in[I_GNB] + c0);
        f32x2 win[38];
        const int base = r0 + 64 * th - 30;
#pragma unroll
        for (int i = 0; i < 38; ++i) { const int gr = base + i; unsigned w = 0u; if (gr >= bs_row) w = *(const unsigned*)(Gb + (size_t)gr * 512 + c0); win[i] = (f32x2){bflo(w), bfhi(w)}; }
#pragma unroll 1
        for (int blk = 0; blk < 8; ++blk) {
            unsigned nx[8];
            const int nb = blk < 7 ? blk + 1 : blk;
#pragma unroll
            for (int i = 0; i < 8; ++i) nx[i] = *(const unsigned*)(Gb + (size_t)(base + 8 * nb + 30 + i) * 512 + c0);
#pragma unroll
            for (int o = 0; o < 8; ++o) {
                f32x2 a = cb;
#pragma unroll
                for (int j = 0; j < 31; ++j) a += wr_[j] * win[o + j];
                const float mean = half_sum(a.x + a.y) * (1.0f / 64.0f);
                const float dx = a.x - mean, dy = a.y - mean;
                const float rstd = 1.0f / sqrtf(half_sum(dx * dx + dy * dy) * (1.0f / 64.0f) + EPS);
                const float yx = dx * rstd * gg.x + gb.x, yy = dy * rstd * gg.y + gb.y;
                const int t = 64 * th + 8 * blk + o;
                *(LAS unsigned*)(F.lds + t * TROW + 2 * (c0 - oz)) = pk2(siluf(yx), siluf(yy));
            }
#pragma unroll
            for (int i = 0; i < 30; ++i) win[i] = win[i + 8];
#pragma unroll
            for (int i = 0; i < 8; ++i) win[30 + i] = (f32x2){bflo(nx[i]), bfhi(nx[i])};
        }
    }
    __syncthreads();
    mixer_tail(F, r0, F.in[I_ONB] + oz, 512);
    __syncthreads();
}

__device__ __forceinline__ void p2_phase(Frame& F) {
    {
        const int gt = F.vcu * NTHR + F.tid, NT = F.G * NTHR;
        const float* PART = (const float*)(F.ws + WS_P2PART); float* B2 = (float*)(F.ws + WS_BIAS2);
        for (int e = gt; e < 2 * NFF; e += NT) { const int b = e / NFF, n = e % NFF; float s = 0.f;
#pragma unroll
            for (int kb = 0; kb < 16; ++kb) s += PART[(size_t)(kb * 2 + b) * NFF + n];
            B2[e] = s; }
    }
    #pragma unroll 1
    for (int uid = F.vcu; uid < 256; uid += F.G) {
        if (uid & 1) mixer_b_unit(F, uid >> 1); else mixer_a_unit(F, uid >> 1);
    }
}

__device__ __forceinline__ void p6_phase(Frame& F) {
    const float* COND = (const float*)(F.ws + WS_COND);
    const int gw = F.vcu * NWAVES + F.wave, NGW = F.G * NWAVES;
    for (int rb = gw; rb < M / 8; rb += NGW) {
        const int b = (rb * 8) >= SEQ ? 1 : 0;
        f32x4 av[4], sv[4];
#pragma unroll
        for (int j = 0; j < 4; ++j) { const int col = 4 * F.lane + 256 * j; const f32x4 g = *(const f32x4*)(F.in[I_NFG] + col), sc = *(const f32x4*)(COND + b * 8192 + 7168 + col); av[j] = g * (sc + 1.0f); sv[j] = *(const f32x4*)(COND + b * 8192 + 6144 + col); }
#pragma unroll 2
        for (int i = 0; i < 8; ++i) { const int row = rb * 8 + i; f32x4* xr = (f32x4*)(F.out + (size_t)row * D) + F.lane;
            f32x4 v[4]; float s = 0.f;
#pragma unroll
            for (int j = 0; j < 4; ++j) { v[j] = xr[64 * j]; s += (v[j][0] * v[j][0] + v[j][1] * v[j][1]) + (v[j][2] * v[j][2] + v[j][3] * v[j][3]); }
            const float rstd = 1.0f / sqrtf(wave_sum(s) * (1.0f / D) + EPS);
#pragma unroll
            for (int j = 0; j < 4; ++j) xr[64 * j] = v[j] * rstd * av[j] + sv[j]; }
    }
}

struct Args { const float* in[24]; float* out; unsigned char* ws; int ph_lo, ph_hi; };
__global__ void __launch_bounds__(NTHR, 2) mk_fwd(Args args) {
    extern __shared__ __attribute__((aligned(16))) unsigned char lds_raw[];
    cg::grid_group grid = cg::this_grid();
    Frame F;
    F.lds = (LAS unsigned char*)lds_raw;
    F.tid = threadIdx.x; F.lane = F.tid & 63; F.wave = __builtin_amdgcn_readfirstlane(F.tid >> 6);
    F.G = gridDim.x; { const int bx = blockIdx.x; F.vcu = (F.G % 8 == 0) ? (bx % 8) * (F.G / 8) + bx / 8 : bx; }
#pragma unroll
    for (int i = 0; i < 24; ++i) F.in[i] = args.in[i];
    F.out = args.out; F.ws = args.ws;
    const int lo = args.ph_lo, hi = args.ph_hi;
#define IN(k) (lo <= (k) && (k) < hi)
#define SEAM(k) do { if (IN(k) && IN((k) + 1)) grid.sync(); } while (0)
    const float* COND = (const float*)(F.ws + WS_COND);

    if (IN(0)) { p0_phase(F); } SEAM(0);
    if (IN(1)) { p0b_phase(F); } SEAM(1);
    if (IN(2)) {
        pg8::Gemm g{(const pg8::bf16_t*)(F.ws + WS_XN), (const pg8::bf16_t*)(F.ws + WS_WIN), M, DIN, D, 0};
        pg8::StaticOrder S; S.init(M, DIN, F.G, (int)blockIdx.x);
        pg8::EpiP1 E{(pg8::bf16_t*)(F.ws + WS_UV), (pg8::bf16_t*)(F.ws + WS_G), (const float*)(F.ws + WS_BIAS1)};
        pg8::gemm_phase<pg8::EpiP1, pg8::StaticOrder, true, true>(F.lds, g, S, E);
    } SEAM(2);
    if (IN(3)) { p2_phase(F); } SEAM(3);
    if (IN(4)) {
        pg8::Gemm g{(const pg8::bf16_t*)(F.ws + WS_Y), (const pg8::bf16_t*)(F.ws + WS_WOUT), M, D, D, 0};
        pg8::StaticOrder S; S.init(M, D, F.G, (int)blockIdx.x);
        pg8::EpiRes<true> E{F.in[I_X], F.out, COND + 2048, (pg8::bf16_t*)(F.ws + WS_XN), (float*)(F.ws + WS_SSQ1)};
        pg8::gemm_phase<pg8::EpiRes<true>, pg8::StaticOrder, true, true>(F.lds, g, S, E);
    } SEAM(4);
    if (IN(5)) {
        pg8::Gemm g{(const pg8::bf16_t*)(F.ws + WS_XN), (const pg8::bf16_t*)(F.ws + WS_WF1), M, NFF, D, (size_t)NFF * D * 2};
        pg8::StaticOrder S; S.init(M, NFF, F.G, (int)blockIdx.x);
        pg8::EpiP4 E{(pg8::bf16_t*)(F.ws + WS_H), (const float*)(F.ws + WS_BIAS2), (const float*)(F.ws + WS_SSQ1)};
        pg8::gemm_phase<pg8::EpiP4, pg8::StaticOrder, true, true>(F.lds, g, S, E);
    } SEAM(5);
    if (IN(6)) {
        pg8::Gemm g{(const pg8::bf16_t*)(F.ws + WS_H), (const pg8::bf16_t*)(F.ws + WS_WF2), M, D, DFF, 0};
        pg8::StaticOrder S; S.init(M, D, F.G, (int)blockIdx.x);
        pg8::EpiRes<false> E{F.out, F.out, COND + 5120, nullptr, nullptr};
        pg8::gemm_phase<pg8::EpiRes<false>, pg8::StaticOrder, true, true>(F.lds, g, S, E);
    } SEAM(6);
    if (IN(7)) { p6_phase(F); }
#undef IN
#undef SEAM
}

extern "C" void kernel_launch(void* const* d_in, const int* in_sizes, int n_in, void* d_out, int out_size, void* d_ws, size_t ws_size, hipStream_t stream) {
    static int grid = 0;
    if (grid == 0) {
        if (n_in != 24 || in_sizes[0] != M * D || out_size != M * D || ws_size < WS_END) { fprintf(stderr, "kernel_launch: unexpected shapes (n_in %d, in0 %d, out %d, ws %zu)\n", n_in, n_in > 0 ? in_sizes[0] : -1, out_size, ws_size); grid = -1; return; }
        int dev = 0, cus = 0, per_cu = 0;
        (void)hipGetDevice(&dev); (void)hipDeviceGetAttribute(&cus, hipDeviceAttributeMultiprocessorCount, dev);
        if (hipFuncSetAttribute((const void*)mk_fwd, hipFuncAttributeMaxDynamicSharedMemorySize, LDS_BYTES) != hipSuccess) { fprintf(stderr, "kernel_launch: hipFuncSetAttribute failed\n"); grid = -1; return; }
        if (hipOccupancyMaxActiveBlocksPerMultiprocessor(&per_cu, (const void*)mk_fwd, NTHR, LDS_BYTES) != hipSuccess || per_cu < 1) { fprintf(stderr, "kernel_launch: occupancy query gave %d\n", per_cu); per_cu = 1; }
        (void)hipGetLastError();
        if (cus <= 0) cus = 256;
        grid = cus * per_cu;
        fprintf(stderr, "kernel_launch: %d CUs x %d = grid %d\n", cus, per_cu, grid);
    }
    if (grid < 0) return;
    Args a{};
    for (int i = 0; i < 24; ++i) a.in[i] = (const float*)d_in[i];
    a.out = (float*)d_out; a.ws = (unsigned char*)d_ws;
#if MK_N_LAUNCHES == 1
    a.ph_lo = 0; a.ph_hi = NPH;
    void* params[] = {&a};
    const hipError_t le = hipLaunchCooperativeKernel((const void*)mk_fwd, dim3(grid), dim3(NTHR), params, LDS_BYTES, stream);
    if (le != hipSuccess) fprintf(stderr, "kernel_launch: cooperative launch failed: %s (grid %d)\n", hipGetErrorName(le), grid);
#else
    for (int p = 0; p < NPH; ++p) {
        a.ph_lo = p; a.ph_hi = p + 1;
        hipLaunchKernelGGL(mk_fwd, dim3(grid), dim3(NTHR), LDS_BYTES, stream, a);
    }
#endif
}
```

```cpp
#define MK_N_LAUNCHES 1
#include <hip/hip_runtime.h>
#include <hip/hip_cooperative_groups.h>
#include <cstdio>
#include <cstdint>
namespace cg = cooperative_groups;
namespace pg8 {
#define PG8_LAS __attribute__((address_space(3)))
typedef unsigned short bf16_t;
typedef short bf16x8 __attribute__((ext_vector_type(8)));
typedef float f32x4 __attribute__((ext_vector_type(4)));
typedef unsigned u32x4 __attribute__((ext_vector_type(4)));
constexpr int BM = 256, BK = 64, HALF = 128, HTB = HALF * BK * 2  , STAGE_BYTES = 8 * HTB, NXCD = 8, WGM = 8;

__host__ __device__ __forceinline__ int lds_byte(int r, int c) { const int st = (r >> 4) * 2 + (c >> 5), rr = r & 15, cc = c & 31, ob = rr * 64 + cc * 2; return st * 1024 + (ob ^ (((ob >> 9) & 1) << 5)); }
__host__ __device__ __forceinline__ void stage_rc(int b, int& R, int& C) { const int st = b / 1024, sb = b % 1024, swz = sb ^ (((sb >> 9) & 1) << 5); R = (st >> 1) * 16 + swz / 64; C = (st & 1) * 32 + (swz % 64) / 2; }
__host__ __device__ __forceinline__ int perm32(int rho) { const int n = rho >> 4, i = rho & 15; return 8 * (i >> 2) + 4 * n + (i & 3); }

struct Unit { int pm, pn; };
struct Gemm { const bf16_t* A; const bf16_t* Bt; int M, N, K; size_t bBatch; };

struct StaticOrder {
    int nM, nN, nwg, G, c;
    __host__ __device__ void init(int M, int N, int G_, int c_) { nM = M / BM; nN = N / BM; nwg = nM * nN; G = G_; c = c_; }
    __host__ __device__ bool next(int i, Unit& u) const {
        const long L = (long)i * G + c; if (L >= nwg) return false;
        int wgid = (int)L; { const int q = nwg / NXCD, r = nwg % NXCD, xcd = wgid % NXCD, off = wgid / NXCD; wgid = (xcd < r ? xcd * (q + 1) : r * (q + 1) + (xcd - r) * q) + off; }
        const int nig = WGM * nN, gid = wgid / nig, fm = gid * WGM, gsz = (nM - fm) < WGM ? (nM - fm) : WGM;
        u.pm = fm + ((wgid % nig) % gsz); u.pn = (wgid % nig) / gsz; return true;
    }
    __device__ __forceinline__ void a_ready(const Unit&) const {}
    __device__ __forceinline__ void done(const Unit&) const {}
};

__device__ __forceinline__ unsigned cvt_pk_bf16(float lo, float hi) { unsigned r; asm volatile("v_cvt_pk_bf16_f32 %0, %1, %2" : "=v"(r) : "v"(lo), "v"(hi)); return r; }
typedef float f32x2 __attribute__((ext_vector_type(2)));
__device__ __forceinline__ f32x2 gelu_pk(f32x2 v) {
    const f32x2 av = __builtin_elementwise_abs(v), d = av * 0.2316418882f + 1.0f;
    f32x2 t; t.x = __builtin_amdgcn_rcpf(d.x); t.y = __builtin_amdgcn_rcpf(d.y);
    f32x2 q = t * 0.5307027145f + (-0.7265760135f); q = q * t + 0.7107068705f; q = q * t + (-0.142248368f); q = q * t + 0.127414796f; q = q * t;
    const f32x2 s = (v * v) * (-0.72134752044f);
    f32x2 e; e.x = __builtin_amdgcn_exp2f(s.x); e.y = __builtin_amdgcn_exp2f(s.y);
    const f32x2 m = v * (q * e), r = v - m;
    f32x2 o; o.x = v.x < 0.f ? m.x : r.x; o.y = v.y < 0.f ? m.y : r.y; return o;
}

__device__ __forceinline__ float sigm(float x) { return __builtin_amdgcn_rcpf(1.0f + __expf(-x)); }
__device__ __forceinline__ f32x4 sigm4(f32x4 x) { return (f32x4){sigm(x[0]), sigm(x[1]), sigm(x[2]), sigm(x[3])}; }
__device__ __forceinline__ u32x4 pack8(f32x4 v0, f32x4 v1) { u32x4 w; w.x = cvt_pk_bf16(v0[0], v0[1]); w.y = cvt_pk_bf16(v0[2], v0[3]); w.z = cvt_pk_bf16(v1[0], v1[1]); w.w = cvt_pk_bf16(v1[2], v1[3]); return w; }

struct EpiP1 {
    static constexpr bool PERM = true, AFTER_DRAIN = false;
    bf16_t* UV; bf16_t* Gb; const float* bias;
    __device__ __forceinline__ void operator()(const f32x4 (&acc)[2][2][4][2], const Unit& u, int wr, int wc, int fr, int fq) const {
        const int row0 = u.pm * BM + wr * 64 + fr;
        const int bcol0 = u.pn * BM + wc * 32 + 8 * fq;
        f32x4 bv[2][2];
#pragma unroll
        for (int bj = 0; bj < 2; ++bj)
#pragma unroll
            for (int n = 0; n < 2; ++n) bv[bj][n] = *(const f32x4*)(bias + bcol0 + bj * HALF + 4 * n);
        if (u.pn < 4) {
#pragma unroll
            for (int ai = 0; ai < 2; ++ai)
#pragma unroll
                for (int m = 0; m < 4; ++m) { bf16_t* rowp = UV + (size_t)(row0 + ai * HALF + m * 16) * 1024 + bcol0;
#pragma unroll
                    for (int bj = 0; bj < 2; ++bj) { f32x4 v0 = acc[ai][bj][m][0] + bv[bj][0], v1 = acc[ai][bj][m][1] + bv[bj][1];
                        f32x2 a = gelu_pk((f32x2){v0[0], v0[1]}), b = gelu_pk((f32x2){v0[2], v0[3]}), c = gelu_pk((f32x2){v1[0], v1[1]}), d = gelu_pk((f32x2){v1[2], v1[3]});
                        v0 = (f32x4){a.x, a.y, b.x, b.y}; v1 = (f32x4){c.x, c.y, d.x, d.y};
                        *(u32x4*)(rowp + bj * HALF) = pack8(v0, v1); } }
        } else {
            const int col0 = (u.pn - 4) * HALF + wc * 32 + 8 * fq;
#pragma unroll
            for (int ai = 0; ai < 2; ++ai)
#pragma unroll
                for (int m = 0; m < 4; ++m) { bf16_t* rowp = Gb + (size_t)(row0 + ai * HALF + m * 16) * 512 + col0;
                    const f32x4 v0 = acc[ai][0][m][0] + bv[0][0], v1 = acc[ai][0][m][1] + bv[0][1], g0 = acc[ai][1][m][0] + bv[1][0], g1 = acc[ai][1][m][1] + bv[1][1];
                    *(u32x4*)rowp = pack8(v0 * sigm4(g0), v1 * sigm4(g1)); }
        }
    }
};

template <bool WITH_XB> struct EpiRes {
    static constexpr bool PERM = false, AFTER_DRAIN = false;
    const float* xi; float* xo; const float* gate;
    bf16_t* xb; float* ssq;
    __device__ __forceinline__ void operator()(const f32x4 (&acc)[2][2][4][2], const Unit& u, int wr, int wc, int fr, int fq) const {
        typedef unsigned u32x2v __attribute__((ext_vector_type(2)));
        const int col0 = u.pn * BM + wc * 32 + 4 * fq;
        const float* gp = gate + (u.pm >= 32 ? 8192 : 0) + col0;
        f32x4 gv[2][2];
#pragma unroll
        for (int bj = 0; bj < 2; ++bj)
#pragma unroll
            for (int n = 0; n < 2; ++n) gv[bj][n] = *(const f32x4*)(gp + bj * HALF + n * 16);
#pragma unroll
        for (int ai = 0; ai < 2; ++ai)
#pragma unroll
            for (int m = 0; m < 4; ++m) { const int r = u.pm * BM + ai * HALF + wr * 64 + m * 16 + fr; const size_t off = (size_t)r * 1024 + col0; float ss = 0.f;
#pragma unroll
                for (int bj = 0; bj < 2; ++bj)
#pragma unroll
                    for (int n = 0; n < 2; ++n) {
                        if (WITH_XB) { const f32x4 xs = *(const f32x4*)(xi + off + bj * HALF + n * 16); const f32x4 o = xs + gv[bj][n] * acc[ai][bj][m][n];
                            ss += (o[0] * o[0] + o[1] * o[1]) + (o[2] * o[2] + o[3] * o[3]); u32x2v w; w.x = cvt_pk_bf16(o[0], o[1]); w.y = cvt_pk_bf16(o[2], o[3]); *(u32x2v*)(xb + off + bj * HALF + n * 16) = w; }
                        else { const u32x2v w = *(const u32x2v*)(xb + off + bj * HALF + n * 16);
                            const f32x4 xs = (f32x4){__uint_as_float(w.x << 16), __uint_as_float(w.x & 0xffff0000u), __uint_as_float(w.y << 16), __uint_as_float(w.y & 0xffff0000u)};
                            *(f32x4*)(xo + off + bj * HALF + n * 16) = xs + gv[bj][n] * acc[ai][bj][m][n]; } }
                if (WITH_XB) { ss += __shfl_xor(ss, 16); ss += __shfl_xor(ss, 32); if (fq == 0) ssq[(size_t)r * 16 + u.pn * 4 + wc] = ss; }
                if (m & 1) asm volatile("" ::: "memory"); }
    }
};

struct EpiP4 {
    static constexpr bool PERM = true, AFTER_DRAIN = false;
    bf16_t* H; const float* bias; const float* ssq;
    __device__ __forceinline__ void operator()(const f32x4 (&acc)[2][2][4][2], const Unit& u, int wr, int wc, int fr, int fq) const {
        const int row0 = u.pm * BM + wr * 64 + fr;
        const int bcol0 = u.pn * BM + wc * 32 + 8 * fq;
        const float* bp = bias + (u.pm >= 32 ? 5632 : 0) + bcol0;
        f32x4 bv[2][2];
#pragma unroll
        for (int bj = 0; bj < 2; ++bj)
#pragma unroll
            for (int n = 0; n < 2; ++n) bv[bj][n] = *(const f32x4*)(bp + bj * HALF + 4 * n);
        const int col0 = u.pn * HALF + wc * 32 + 8 * fq;
#pragma unroll
        for (int ai = 0; ai < 2; ++ai)
#pragma unroll
            for (int m = 0; m < 4; ++m) { const int r = row0 + ai * HALF + m * 16;
                const f32x4* sp = (const f32x4*)(ssq + (size_t)r * 16); const f32x4 s0 = sp[0], s1 = sp[1], s2 = sp[2], s3 = sp[3];
                const float st = (((s0[0] + s0[1]) + (s0[2] + s0[3])) + ((s1[0] + s1[1]) + (s1[2] + s1[3]))) + (((s2[0] + s2[1]) + (s2[2] + s2[3])) + ((s3[0] + s3[1]) + (s3[2] + s3[3])));
                const float rstd = 1.0f / sqrtf(st * (1.0f / 1024.0f) + 1e-6f);
                const f32x4 g0 = acc[ai][0][m][0] * rstd + bv[0][0], g1 = acc[ai][0][m][1] * rstd + bv[0][1], u0 = acc[ai][1][m][0] * rstd + bv[1][0], u1 = acc[ai][1][m][1] * rstd + bv[1][1];
                *(u32x4*)(H + (size_t)r * 2816 + col0) = pack8(g0 * sigm4(g0) * u0, g1 * sigm4(g1) * u1); }
    }
};
template <class Epi, class Sched, bool ALIGN_EPI = false, bool SP2 = false>
__device__ __forceinline__ void gemm_phase(PG8_LAS unsigned char* lds, const Gemm g, const Sched& S, const Epi& E) {
    const int tid = threadIdx.x, wid = __builtin_amdgcn_readfirstlane(tid >> 6), lane = tid & 63, wr = wid >> 2, wc = wid & 3, fr = lane & 15, fq = lane >> 4;
    const int K = g.K, nt = K / BK;
    unsigned voffA[2], voffB[2];
#pragma unroll
    for (int i = 0; i < 2; ++i) { int R, C; stage_rc(tid * 16 + i * 8192, R, C); const int Rb = Epi::PERM ? ((R & ~31) + perm32(R & 31)) : R;
        voffA[i] = (unsigned)(R * K + C) * 2u; voffB[i] = (unsigned)(Rb * K + C) * 2u; }
    const size_t kstep = (size_t)(BK * 2);
    const size_t hstep = (size_t)HALF * K * 2;
    const size_t tstep = 2 * hstep;
    const unsigned ldsw = (unsigned)wid * 1024u;
    const int aoff = lds_byte(wr * 64 + fr, fq * 8), boff = lds_byte(wc * 32 + fr, fq * 8);
#define PG8_SA(b, h) (((b) * 2 + (h)) * HTB)
#define PG8_SB(b, h) ((4 + (b) * 2 + (h)) * HTB)
#define PG8_STAGE(bufoff, gbase, voff) do { _Pragma("unroll") for (int _i = 0; _i < 2; ++_i) \
        __builtin_amdgcn_global_load_lds((const unsigned*)((const char*)(gbase) + (voff)[_i]), (PG8_LAS unsigned*)(lds + (bufoff) + ldsw + _i * 8192), 16, 0, 0); } while (0)
#define PG8_LDA(dst, b, h) do { _Pragma("unroll") for (int m = 0; m < 4; ++m) _Pragma("unroll") for (int k = 0; k < 2; ++k) dst[m][k] = *(const PG8_LAS bf16x8*)(lds + PG8_SA(b, h) + aoff + m * 2048 + k * 1024); } while (0)
#define PG8_LDB(dst, b, h) do { _Pragma("unroll") for (int n = 0; n < 2; ++n) _Pragma("unroll") for (int k = 0; k < 2; ++k) dst[n][k] = *(const PG8_LAS bf16x8*)(lds + PG8_SB(b, h) + boff + n * 2048 + k * 1024); } while (0)
#define PG8_MMA(ai, bj, At, Bt) do { __builtin_amdgcn_s_setprio(1); _Pragma("unroll") for (int m = 0; m < 4; ++m) _Pragma("unroll") for (int n = 0; n < 2; ++n) _Pragma("unroll") for (int k = 0; k < 2; ++k) \
        acc[ai][bj][m][n] = __builtin_amdgcn_mfma_f32_16x16x32_bf16(Bt[n][k], At[m][k], acc[ai][bj][m][n], 0, 0, 0); __builtin_amdgcn_s_setprio(0); } while (0)
#define PG8_WAIT_V(n) asm volatile("s_waitcnt vmcnt(" #n ")" ::: "memory")
#define PG8_WAIT_L(n) asm volatile("s_waitcnt lgkmcnt(" #n ")" ::: "memory")
#define PG8_BAR __builtin_amdgcn_s_barrier()
#define PG8_SCHED __builtin_amdgcn_sched_barrier(0)
    Unit cur, nxt; int ui = 0;
    if (!S.next(0, cur)) return;
    f32x4 acc[2][2][4][2];
#pragma unroll
    for (int a = 0; a < 2; ++a)
#pragma unroll
        for (int b = 0; b < 2; ++b)
#pragma unroll
            for (int m = 0; m < 4; ++m)
#pragma unroll
                for (int n = 0; n < 2; ++n) acc[a][b][m][n] = (f32x4){0.f, 0.f, 0.f, 0.f};
    bf16x8 At[4][2], B0[2][2], B1[2][2];
    const char* cA = (const char*)g.A + (size_t)cur.pm * tstep; const char* cB = (const char*)g.Bt + (size_t)cur.pn * tstep + (cur.pm >= 32 ? g.bBatch : (size_t)0);
    S.a_ready(cur);
    if constexpr (SP2) {
        PG8_STAGE(PG8_SB(0, 0), cB, voffB); PG8_STAGE(PG8_SB(0, 1), cB + hstep, voffB); PG8_STAGE(PG8_SA(0, 0), cA, voffA); PG8_STAGE(PG8_SA(0, 1), cA + hstep, voffA);
        if (wr == 1) PG8_BAR;
        PG8_WAIT_V(2); PG8_BAR;
        PG8_STAGE(PG8_SB(1, 0), cB + kstep, voffB); PG8_STAGE(PG8_SA(1, 0), cA + kstep, voffA); PG8_STAGE(PG8_SB(1, 1), cB + hstep + kstep, voffB);
        PG8_WAIT_V(6); PG8_BAR;
    } else {
        PG8_STAGE(PG8_SB(0, 0), cB, voffB); PG8_STAGE(PG8_SA(0, 0), cA, voffA); PG8_STAGE(PG8_SB(0, 1), cB + hstep, voffB); PG8_STAGE(PG8_SA(0, 1), cA + hstep, voffA);
        if (wr == 1) PG8_BAR;
        PG8_WAIT_V(4); PG8_BAR;
        PG8_STAGE(PG8_SB(1, 0), cB + kstep, voffB); PG8_STAGE(PG8_SA(1, 0), cA + kstep, voffA); PG8_STAGE(PG8_SB(1, 1), cB + hstep + kstep, voffB);
        PG8_WAIT_V(6); PG8_BAR;
    }
    for (;;) {
        const bool has_next = S.next(ui + 1, nxt);
        const char* nA = has_next ? (const char*)g.A + (size_t)nxt.pm * tstep : cA; const char* nB = has_next ? (const char*)g.Bt + (size_t)nxt.pn * tstep + (nxt.pm >= 32 ? g.bBatch : (size_t)0) : cB;
        for (int t = 0; t < nt; t += 2) {
            const bool last = (t == nt - 2);
            const char* a1 = cA + (size_t)(t + 1) * kstep;
            const char* a2 = last ? nA : cA + (size_t)(t + 2) * kstep; const char* b2 = last ? nB : cB + (size_t)(t + 2) * kstep;
            const char* a3 = a2 + kstep; const char* b3 = b2 + kstep;
            if (last && has_next) S.a_ready(nxt);
            if constexpr (SP2) {
            PG8_LDB(B0, 0, 0); PG8_LDB(B1, 0, 1); PG8_SCHED; PG8_LDA(At, 0, 0); PG8_STAGE(PG8_SA(1, 1), a1 + hstep, voffA);
            PG8_WAIT_V(8); PG8_WAIT_L(0); PG8_BAR; PG8_MMA(0, 0, At, B0); PG8_MMA(0, 1, At, B1); PG8_BAR; PG8_SCHED;
            PG8_LDA(At, 0, 1); PG8_STAGE(PG8_SB(0, 0), b2, voffB); PG8_STAGE(PG8_SB(0, 1), b2 + hstep, voffB); PG8_STAGE(PG8_SA(0, 0), a2, voffA);
            PG8_WAIT_V(8); PG8_WAIT_L(0); PG8_BAR; PG8_MMA(1, 0, At, B0); PG8_MMA(1, 1, At, B1); PG8_BAR; PG8_SCHED;
            PG8_LDB(B0, 1, 0); PG8_LDB(B1, 1, 1); PG8_SCHED; PG8_LDA(At, 1, 0); PG8_STAGE(PG8_SA(0, 1), a2 + hstep, voffA);
            PG8_WAIT_V(8); PG8_WAIT_L(0); PG8_BAR; PG8_MMA(0, 0, At, B0); PG8_MMA(0, 1, At, B1); PG8_BAR; PG8_SCHED;
            PG8_LDA(At, 1, 1); PG8_STAGE(PG8_SB(1, 0), b3, voffB); PG8_STAGE(PG8_SB(1, 1), b3 + hstep, voffB); PG8_STAGE(PG8_SA(1, 0), a3, voffA);
            PG8_WAIT_V(8); PG8_WAIT_L(0); PG8_BAR; PG8_MMA(1, 0, At, B0); PG8_MMA(1, 1, At, B1); PG8_BAR; PG8_SCHED;
            } else {
            PG8_LDB(B0, 0, 0); PG8_SCHED; PG8_LDA(At, 0, 0); PG8_STAGE(PG8_SA(1, 1), a1 + hstep, voffA);
            PG8_WAIT_L(8); PG8_BAR; PG8_WAIT_L(0); PG8_MMA(0, 0, At, B0); PG8_BAR; PG8_SCHED;
            PG8_LDB(B1, 0, 1); PG8_STAGE(PG8_SB(0, 0), b2, voffB);
            PG8_BAR; PG8_WAIT_L(0); PG8_MMA(0, 1, At, B1); PG8_BAR;
            PG8_LDA(At, 0, 1); PG8_STAGE(PG8_SA(0, 0), a2, voffA);
            PG8_BAR; PG8_WAIT_L(0); PG8_MMA(1, 0, At, B0); PG8_BAR; PG8_SCHED;
            PG8_STAGE(PG8_SB(0, 1), b2 + hstep, voffB);
            PG8_WAIT_V(6); PG8_BAR; PG8_MMA(1, 1, At, B1); PG8_BAR;
            PG8_LDB(B0, 1, 0); PG8_SCHED; PG8_LDA(At, 1, 0); PG8_STAGE(PG8_SA(0, 1), a2 + hstep, voffA);
            PG8_WAIT_L(8); PG8_BAR; PG8_WAIT_L(0); PG8_MMA(0, 0, At, B0); PG8_BAR; PG8_SCHED;
            PG8_LDB(B1, 1, 1); PG8_STAGE(PG8_SB(1, 0), b3, voffB);
            PG8_BAR; PG8_WAIT_L(0); PG8_MMA(0, 1, At, B1); PG8_BAR;
            PG8_LDA(At, 1, 1); PG8_STAGE(PG8_SA(1, 0), a3, voffA);
            PG8_BAR; PG8_WAIT_L(0); PG8_MMA(1, 0, At, B0); PG8_BAR; PG8_SCHED;
            PG8_STAGE(PG8_SB(1, 1), b3 + hstep, voffB);
            PG8_WAIT_V(6); PG8_BAR; PG8_MMA(1, 1, At, B1); PG8_BAR;
            }
        }
        if constexpr (ALIGN_EPI) { if (wr == 0) PG8_BAR; }
        if constexpr (!Epi::AFTER_DRAIN) { E(acc, cur, wr, wc, fr, fq); S.done(cur); }
        if (!has_next) break;
#pragma unroll
        for (int a = 0; a < 2; ++a)
#pragma unroll
            for (int b = 0; b < 2; ++b)
#pragma unroll
                for (int m = 0; m < 4; ++m)
#pragma unroll
                    for (int n = 0; n < 2; ++n) acc[a][b][m][n] = (f32x4){0.f, 0.f, 0.f, 0.f};
        cur = nxt; cA = nA; cB = nB; ++ui;
        if constexpr (ALIGN_EPI) { if (wr == 1) PG8_BAR; }
    }
    PG8_WAIT_V(0);
    if constexpr (!ALIGN_EPI) { if (wr == 0) PG8_BAR; }
    PG8_BAR;
    if constexpr (Epi::AFTER_DRAIN) { E.fused(acc, cur, wr, wc, fr, fq, lds, wid, lane); S.done(cur); }
#undef PG8_SA
#undef PG8_SB
#undef PG8_STAGE
#undef PG8_LDA
#undef PG8_LDB
#undef PG8_MMA
#undef PG8_WAIT_V
#undef PG8_WAIT_L
#undef PG8_BAR
#undef PG8_SCHED
}
}

#ifndef MK_REP
#define MK_REP -1
#endif
#ifndef MK_N_LAUNCHES
#define MK_N_LAUNCHES 1
#endif
constexpr int NWAVES = 8, NTHR = NWAVES * 64;
constexpr int SEQ = 8192, D = 1024, M = 2 * SEQ, DIN = 2048, DFF = 2816, NFF = 2 * DFF;
constexpr float EPS = 1e-6f;
constexpr int NPH = 8;

constexpr size_t MiB = 1u << 20;
constexpr size_t WS_CTL = 0, CTL_ZERO_BYTES = 16384;
constexpr size_t WS_COND = 1 * MiB;
constexpr size_t WS_BIAS1 = 1 * MiB + 65536;
constexpr size_t WS_BIAS2 = 1 * MiB + 131072;
constexpr size_t WS_P2PART = 2 * MiB;
constexpr size_t WS_SSQ1 = 3 * MiB;
constexpr size_t WS_WSP = 4 * MiB;
constexpr size_t WS_WIN = 6 * MiB;
constexpr size_t WS_WOUT = 10 * MiB;
constexpr size_t WS_WF2 = 12 * MiB;
constexpr size_t WS_WF1 = 18 * MiB;
constexpr size_t WS_XN = 40 * MiB;
constexpr size_t WS_UV = 72 * MiB;
constexpr size_t WS_G = 104 * MiB;
constexpr size_t WS_Y = 120 * MiB;
constexpr size_t WS_H = 152 * MiB;
constexpr size_t WS_X2 = 72 * MiB;
constexpr size_t WS_END = 240 * MiB;

constexpr int LDS_BYTES = 155648;
constexpr int TROW = 1040;
constexpr int TILE_BYTES = 128 * TROW;
constexpr int MISC_OFF = 135168;

#define LAS __attribute__((address_space(3)))
typedef unsigned short bf16;
typedef unsigned v4u __attribute__((ext_vector_type(4)));
typedef unsigned v2u __attribute__((ext_vector_type(2)));
typedef float f32x4 __attribute__((ext_vector_type(4)));
typedef float f32x2 __attribute__((ext_vector_type(2)));
typedef short bf16x8 __attribute__((ext_vector_type(8)));
#define LDS_WAIT() asm volatile("s_waitcnt lgkmcnt(0)" ::: "memory")
#define XB_TMO      128
#define XB_XCNT(j)  (256  + 64 * (j))
#define XB_XSUB(j)  (1280 + 64 * (j))
#define XB_XGEN(j)  (2304 + 64 * (j))
#define XB_TOP      3328
#define XB_TOPGEN   3392
#define XCD_BAR_WORDS 3456
#define XB_SPIN_CAP (1u << 18)

__device__ __forceinline__ unsigned xb_ld(unsigned* p)              { return __hip_atomic_load(p, __ATOMIC_RELAXED, __HIP_MEMORY_SCOPE_AGENT); }
__device__ __forceinline__ unsigned xb_add(unsigned* p, unsigned v) { return __hip_atomic_fetch_add(p, v, __ATOMIC_RELAXED, __HIP_MEMORY_SCOPE_AGENT); }
__device__ __forceinline__ unsigned xb_xcc_id() { return (unsigned)__builtin_amdgcn_s_getreg((3 << 11) | 20) & 0xFu; }
#define XB_SPIN(cond, bar) do { unsigned _sp = 0; while (cond) { __builtin_amdgcn_s_sleep(1); \
    if ((++_sp & 255u) == 0u) { if (xb_ld(&(bar)[XB_TMO])) break; if (_sp > XB_SPIN_CAP) { atomicAdd(&(bar)[XB_TMO], 1u); break; } } } } while (0)

struct XcdBarrier {
    unsigned* bar; unsigned x;
    volatile LAS unsigned* st;
};

__device__ __forceinline__ XcdBarrier xcd_barrier_post(unsigned* bar, volatile LAS unsigned* st) {
    XcdBarrier b; b.bar = bar; b.x = xb_xcc_id(); b.st = st;
    if (threadIdx.x == 0) (void)xb_add(&bar[XB_XCNT(b.x)], 1u);
    return b;
}
__device__ __forceinline__ void xcd_barrier_complete(unsigned* bar, unsigned x, unsigned& nloc, unsigned& nx) {
    const unsigned G = gridDim.x * gridDim.y * gridDim.z;
    unsigned sum, cnt, mine, sp = 0u;
    for (;;) {
        sum = 0u; cnt = 0u; mine = 0u;
#pragma unroll
        for (unsigned j = 0; j < 16; ++j) { const unsigned c = xb_ld(&bar[XB_XCNT(j)]); sum += c; cnt += (c > 0u) ? 1u : 0u; mine = (j == x) ? c : mine; }
        if (sum == G) break;
        __builtin_amdgcn_s_sleep(1);
        if ((++sp & 255u) == 0u) { if (xb_ld(&bar[XB_TMO])) break; if (sp > XB_SPIN_CAP) { atomicAdd(&bar[XB_TMO], 1u); break; } }
    }
    nloc = mine > 0u ? mine : 1u; nx = cnt > 0u ? cnt : 1u;
}

__device__ __forceinline__ void xcd_barrier(const XcdBarrier& b) {
    asm volatile("s_waitcnt vmcnt(0)" ::: "memory");
    __syncthreads();
    if (threadIdx.x == 0) {
        unsigned* bar = b.bar;
        __builtin_amdgcn_s_waitcnt(0);
        unsigned nloc = b.st[0], nx = b.st[1];
        if (nloc == 0u) { xcd_barrier_complete(bar, b.x, nloc, nx); b.st[0] = nloc; b.st[1] = nx; }
        const unsigned old = xb_add(&bar[XB_XSUB(b.x)], 1u);
        const unsigned gen = old / nloc;
        if (old + 1u == (gen + 1u) * nloc) {
            __builtin_amdgcn_fence(__ATOMIC_RELEASE, "agent");
            asm volatile("s_waitcnt vmcnt(0)" ::: "memory");
            const unsigned og = xb_add(&bar[XB_TOP], 1u);
            const unsigned tg = og / nx;
            if (og + 1u == (tg + 1u) * nx) xb_add(&bar[XB_TOPGEN], 1u);
            else XB_SPIN(xb_ld(&bar[XB_TOPGEN]) == tg, bar);
            __builtin_amdgcn_fence(__ATOMIC_ACQUIRE, "agent");
            xb_add(&bar[XB_XGEN(b.x)], 1u);
            asm volatile("s_waitcnt vmcnt(0)" ::: "memory");
        } else {
            XB_SPIN(xb_ld(&bar[XB_XGEN(b.x)]) == gen, bar);
            __builtin_amdgcn_fence(__ATOMIC_ACQUIRE, "agent");
            asm volatile("s_waitcnt vmcnt(0)" ::: "memory");
        }
    }
    __syncthreads();
}


__device__ __forceinline__ unsigned pk2(float lo, float hi) { return pg8::cvt_pk_bf16(lo, hi); }
__device__ __forceinline__ float bflo(unsigned w) { return __uint_as_float(w << 16); }
__device__ __forceinline__ float bfhi(unsigned w) { return __uint_as_float(w & 0xffff0000u); }
__device__ __forceinline__ void unpack8(v4u w, float (&f)[8]) { f[0] = bflo(w.x); f[1] = bfhi(w.x); f[2] = bflo(w.y); f[3] = bfhi(w.y); f[4] = bflo(w.z); f[5] = bfhi(w.z); f[6] = bflo(w.w); f[7] = bfhi(w.w); }
__device__ __forceinline__ v4u pack8f(const float (&f)[8]) { v4u w; w.x = pk2(f[0], f[1]); w.y = pk2(f[2], f[3]); w.z = pk2(f[4], f[5]); w.w = pk2(f[6], f[7]); return w; }
__device__ __forceinline__ float wave_sum(float v) {
#pragma unroll
    for (int o = 1; o < 64; o <<= 1) v += __shfl_xor(v, o);
    return v;
}
__device__ __forceinline__ float half_sum(float v) {
#pragma unroll
    for (int o = 1; o < 32; o <<= 1) v += __shfl_xor(v, o);
    return v;
}
__device__ __forceinline__ float siluf(float x) { return x * __builtin_amdgcn_rcpf(1.0f + __expf(-x)); }

struct Frame {
    LAS unsigned char* lds;
    int tid, lane, wave, vcu, G;
    const float* in[24]; float* out; unsigned char* ws;
};
enum { I_X = 0, I_C, I_ADAW, I_ADAB, I_N1G, I_WIN, I_BIN, I_ALNG, I_ALNB, I_ASW, I_ASB, I_CW, I_CB, I_GNG, I_GNB, I_ONA, I_ONB, I_WOUT, I_N2G, I_WF1, I_WF2, I_ADAFW, I_ADAFB, I_NFG };

__device__ __forceinline__ int map_in(int c) { if (c < 1024) return c; if (c < 1536) { const int j = c - 1024; return 1024 + 256 * (j >> 7) + (j & 127); } const int j = c - 1536; return 1024 + 256 * (j >> 7) + 128 + (j & 127); }
__device__ __forceinline__ int map_ff(int c) { if (c < DFF) return 256 * (c >> 7) + (c & 127); const int j = c - DFF; return 256 * (j >> 7) + 128 + (j & 127); }

__device__ __forceinline__ void transpose_item(const float* W, int K, int N, bf16* WT, int dst0, int k0, int n0, LAS float* scr, int lane) {
#pragma unroll 8
    for (int i = 0; i < 32; ++i) { const int kk = 2 * i + (lane >> 5); scr[kk * 33 + (lane & 31)] = W[(size_t)(k0 + kk) * N + n0 + (lane & 31)]; }
    LDS_WAIT(); asm volatile("" ::: "memory");
    const int c = lane & 7;
#pragma unroll
    for (int j = 0; j < 4; ++j) { const int n = (lane >> 3) + 8 * j; const LAS float* s = scr + (8 * c) * 33 + n;
        v4u o; o.x = pk2(s[0 * 33], s[1 * 33]); o.y = pk2(s[2 * 33], s[3 * 33]); o.z = pk2(s[4 * 33], s[5 * 33]); o.w = pk2(s[6 * 33], s[7 * 33]);
        *(v4u*)(WT + (size_t)(dst0 + n) * K + k0 + 8 * c) = o; }
    LDS_WAIT(); asm volatile("" ::: "memory");
}

__device__ __forceinline__ void p0_phase(Frame& F) {
    LAS float* sc = (LAS float*)F.lds; LAS float* red = (LAS float*)(F.lds + 8192);
    float* COND = (float*)(F.ws + WS_COND);
    for (int i = F.tid; i < 2048; i += NTHR) { const float v = F.in[I_C][i]; sc[i] = siluf(v); }
    __syncthreads();
    for (int cb = F.vcu; cb < 256; cb += F.G) {
        const float* W; const float* bias; int N, n0, cofs;
        if (cb < 192) { W = F.in[I_ADAW]; N = 6144; n0 = 32 * cb; bias = F.in[I_ADAB]; cofs = n0; } else { W = F.in[I_ADAFW]; N = 2048; n0 = 32 * (cb - 192); bias = F.in[I_ADAFB]; cofs = 6144 + n0; }
        const int col = F.lane & 31, par = F.lane >> 5;
        float a0 = 0.f, a1 = 0.f;
        const float* wp = W + (size_t)(128 * F.wave + par) * N + n0 + col;
#pragma unroll 16
        for (int i = 0; i < 64; ++i) { const float wv = wp[(size_t)(2 * i) * N]; const int k = 128 * F.wave + 2 * i + par; a0 += sc[k] * wv; a1 += sc[1024 + k] * wv; }
        a0 += __shfl_xor(a0, 32); a1 += __shfl_xor(a1, 32);
        if (F.lane < 32) { red[(F.wave * 2 + 0) * 32 + col] = a0; red[(F.wave * 2 + 1) * 32 + col] = a1; }
        __syncthreads();
        if (F.tid < 64) { const int b = F.tid >> 5, cc = F.tid & 31; float s = 0.f;
#pragma unroll
            for (int w = 0; w < 8; ++w) s += red[(w * 2 + b) * 32 + cc];
            COND[b * 8192 + cofs + cc] = s + bias[n0 + cc]; }
        __syncthreads();
    }
    LAS float* scr = (LAS float*)(F.lds + 16384 + F.wave * 8704);
    const int gw = F.vcu * NWAVES + F.wave, NGW = F.G * NWAVES;
    constexpr int I_IN = 16 * 64, I_OUT = 16 * 32, I_F2 = 44 * 32, NIT = I_IN + I_OUT + I_F2;
    for (int it = gw; it < NIT; it += NGW) {
        int r = it;
        if (r < I_IN) { const int kb = r / 64, nb = r % 64; transpose_item(F.in[I_WIN], 1024, DIN, (bf16*)(F.ws + WS_WIN), map_in(32 * nb), 64 * kb, 32 * nb, scr, F.lane); continue; } r -= I_IN;
        if (r < I_OUT) { const int kb = r / 32, nb = r % 32; transpose_item(F.in[I_WOUT], 1024, 1024, (bf16*)(F.ws + WS_WOUT), 32 * nb, 64 * kb, 32 * nb, scr, F.lane); continue; } r -= I_OUT;
        { const int kb = r / 32, nb = r % 32; transpose_item(F.in[I_WF2], DFF, 1024, (bf16*)(F.ws + WS_WF2), 32 * nb, 64 * kb, 32 * nb, scr, F.lane); }
    }
    const int gt = F.vcu * NTHR + F.tid, NT = F.G * NTHR;
    bf16* WSP = (bf16*)(F.ws + WS_WSP);
    for (int e = gt; e < 8 * 128 * 128; e += NT) { const int t = (e >> 7) & 127, s = e & 127; const float v = F.in[I_ASW][e]; WSP[e] = (bf16)(s <= t ? (pk2(v, 0.f) & 0xffffu) : 0u); }
    float* B1 = (float*)(F.ws + WS_BIAS1);
    for (int e = gt; e < DIN; e += NT) B1[map_in(e)] = F.in[I_BIN][e];
}

__device__ __forceinline__ void p0b_phase(Frame& F) {
    const float* COND = (const float*)(F.ws + WS_COND);
    const int gw = F.vcu * NWAVES + F.wave, NGW = F.G * NWAVES;
    bf16* XN = (bf16*)(F.ws + WS_XN);
    for (int rb = gw; rb < M / 8; rb += NGW) {
        const int b = (rb * 8) >= SEQ ? 1 : 0;
        f32x4 av[4], sv[4];
#pragma unroll
        for (int j = 0; j < 4; ++j) { const int col = 4 * F.lane + 256 * j; const f32x4 g = *(const f32x4*)(F.in[I_N1G] + col), sc = *(const f32x4*)(COND + b * 8192 + 1024 + col); av[j] = g * (sc + 1.0f); sv[j] = *(const f32x4*)(COND + b * 8192 + col); }
#pragma unroll 2
        for (int i = 0; i < 8; ++i) { const int row = rb * 8 + i; const f32x4* xr = (const f32x4*)(F.in[I_X] + (size_t)row * D) + F.lane;
            f32x4 v[4]; float s = 0.f;
#pragma unroll
            for (int j = 0; j < 4; ++j) { v[j] = xr[64 * j]; s += (v[j][0] * v[j][0] + v[j][1] * v[j][1]) + (v[j][2] * v[j][2] + v[j][3] * v[j][3]); }
            const float rstd = 1.0f / sqrtf(wave_sum(s) * (1.0f / D) + EPS);
            v2u* o8 = (v2u*)(XN + (size_t)row * D) + F.lane;
#pragma unroll
            for (int j = 0; j < 4; ++j) { const f32x4 o = v[j] * rstd * av[j] + sv[j]; v2u w; w.x = pk2(o[0], o[1]); w.y = pk2(o[2], o[3]); o8[64 * j] = w; } }
    }
    LAS float* scr = (LAS float*)(F.lds + F.wave * 8704);
    bf16* WF1 = (bf16*)(F.ws + WS_WF1); float* PART = (float*)(F.ws + WS_P2PART);
    const float* W = F.in[I_WF1];
    for (int it = gw; it < 16 * 176; it += NGW) {
        const int kb = it / 176, nb = it % 176, k0 = 64 * kb, n0 = 32 * nb, dst0 = map_ff(n0);
#pragma unroll 8
        for (int i = 0; i < 32; ++i) { const int kk = 2 * i + (F.lane >> 5); scr[kk * 33 + (F.lane & 31)] = W[(size_t)(k0 + kk) * NFF + n0 + (F.lane & 31)]; }
        LDS_WAIT(); asm volatile("" ::: "memory");
        { const int b = F.lane >> 5, n = F.lane & 31; const float* sh = COND + b * 8192 + 3072 + k0; float p = 0.f;
#pragma unroll 8
            for (int kk = 0; kk < 64; ++kk) p += sh[kk] * scr[kk * 33 + n];
            PART[(size_t)(kb * 2 + b) * NFF + dst0 + n] = p; }
        const int c = F.lane & 7;
#pragma unroll
        for (int b = 0; b < 2; ++b) {
            const f32x4 ga = *(const f32x4*)(F.in[I_N2G] + k0 + 8 * c), gb = *(const f32x4*)(F.in[I_N2G] + k0 + 8 * c + 4);
            const f32x4 sa = *(const f32x4*)(COND + b * 8192 + 4096 + k0 + 8 * c), sb = *(const f32x4*)(COND + b * 8192 + 4096 + k0 + 8 * c + 4);
            const f32x4 a0 = ga * (sa + 1.0f), a1 = gb * (sb + 1.0f);
#pragma unroll
            for (int j = 0; j < 4; ++j) { const int n = (F.lane >> 3) + 8 * j; const LAS float* s = scr + (8 * c) * 33 + n;
                v4u o; o.x = pk2(s[0 * 33] * a0[0], s[1 * 33] * a0[1]); o.y = pk2(s[2 * 33] * a0[2], s[3 * 33] * a0[3]); o.z = pk2(s[4 * 33] * a1[0], s[5 * 33] * a1[1]); o.w = pk2(s[6 * 33] * a1[2], s[7 * 33] * a1[3]);
                *(v4u*)(WF1 + ((size_t)b * NFF + dst0 + n) * 1024 + k0 + 8 * c) = o; }
        }
        LDS_WAIT(); asm volatile("" ::: "memory");
    }
}

__device__ __forceinline__ void mixer_tail(Frame& F, int r0, const float* gain, int coloff) {
    bf16* Y = (bf16*)(F.ws + WS_Y);
    const f32x4 g0 = *(const f32x4*)(gain + 8 * F.lane), g1 = *(const f32x4*)(gain + 8 * F.lane + 4);
#pragma unroll 4
    for (int i = 0; i < 16; ++i) { const int t = 16 * F.wave + i;
        const v4u w = *(const LAS v4u*)(F.lds + t * TROW + 16 * F.lane); float f[8]; unpack8(w, f);
        float s = 0.f;
#pragma unroll
        for (int j = 0; j < 8; ++j) s += f[j] * f[j];
        const float rstd = 1.0f / sqrtf(wave_sum(s) * (1.0f / 512.0f) + EPS);
        float o[8];
#pragma unroll
        for (int j = 0; j < 4; ++j) { o[j] = f[j] * rstd * g0[j]; o[4 + j] = f[4 + j] * rstd * g1[j]; }
        *(v4u*)(Y + (size_t)(r0 + t) * 1024 + coloff + 8 * F.lane) = pack8f(o); }
}

__device__ __forceinline__ int opaque_zero() { int z; asm volatile("s_mov_b32 %0, 0" : "=s"(z)); return z; }
__device__ __forceinline__ void mixer_a_unit(Frame& F, int ci) {
    const int r0 = 128 * ci; const int oz = opaque_zero();
    const bf16* UV = (const bf16*)(F.ws + WS_UV) + oz; const bf16* WSP = (const bf16*)(F.ws + WS_WSP) + oz;
    {
        const f32x4 lg0 = *(const f32x4*)(F.in[I_ALNG] + oz + 8 * F.lane), lg1 = *(const f32x4*)(F.in[I_ALNG] + oz + 8 * F.lane + 4);
        const f32x4 lb0 = *(const f32x4*)(F.in[I_ALNB] + oz + 8 * F.lane), lb1 = *(const f32x4*)(F.in[I_ALNB] + oz + 8 * F.lane + 4);
#pragma unroll 4
        for (int i = 0; i < 16; ++i) { const int s = 16 * F.wave + i;
            const v4u w = *(const v4u*)(UV + (size_t)(r0 + s) * 1024 + 512 + 8 * F.lane); float f[8]; unpack8(w, f);
            float sm = 0.f;
#pragma unroll
            for (int j = 0; j < 8; ++j) sm += f[j];
            const float mean = wave_sum(sm) * (1.0f / 512.0f); float q = 0.f;
#pragma unroll
            for (int j = 0; j < 8; ++j) { f[j] -= mean; q += f[j] * f[j]; }
            const float rstd = 1.0f / sqrtf(wave_sum(q) * (1.0f / 512.0f) + EPS);
            float o[8];
#pragma unroll
            for (int j = 0; j < 4; ++j) { o[j] = f[j] * rstd * lg0[j] + lb0[j]; o[4 + j] = f[4 + j] * rstd * lg1[j] + lb1[j]; }
            *(LAS v4u*)(F.lds + s * TROW + 16 * F.lane) = pack8f(o); }
    }
    __syncthreads();
    {
        const int h = F.wave, fr = F.lane & 15, q = F.lane >> 4;
        const float* bsp = F.in[I_ASB] + h * 128 + oz;
        bf16x8 Xf[20]; f32x4 bs4[8];
        { int idx = 0;
#pragma unroll
            for (int tt = 0; tt < 8; ++tt) {
#pragma unroll
                for (int st = 0; st <= tt / 2; ++st) Xf[idx++] = *(const bf16x8*)(WSP + ((size_t)(h * 128 + 16 * tt + fr) * 128 + 32 * st + 8 * q));
                bs4[tt] = *(const f32x4*)(bsp + 16 * tt + 4 * q); } }
#pragma unroll 1
        for (int dt = 0; dt < 4; ++dt) {
            const int colb = 2 * (h * 64 + 16 * dt + fr);
            bf16x8 Yf[4];
#pragma unroll
            for (int st = 0; st < 4; ++st) { unsigned e[8];
#pragma unroll
                for (int j = 0; j < 8; ++j) e[j] = *(const LAS unsigned short*)(F.lds + (32 * st + 8 * q + j) * TROW + colb);
                v4u w; w.x = e[0] | (e[1] << 16); w.y = e[2] | (e[3] << 16); w.z = e[4] | (e[5] << 16); w.w = e[6] | (e[7] << 16);
                Yf[st] = __builtin_bit_cast(bf16x8, w); }
            LDS_WAIT(); asm volatile("" ::: "memory");
            int idx = 0;
#pragma unroll
            for (int tt = 0; tt < 8; ++tt) {
                f32x4 acc = (f32x4){0.f, 0.f, 0.f, 0.f};
#pragma unroll
                for (int st = 0; st <= tt / 2; ++st) acc = __builtin_amdgcn_mfma_f32_16x16x32_bf16(Xf[idx++], Yf[st], acc, 0, 0, 0);
                acc += bs4[tt];
#pragma unroll
                for (int v = 0; v < 4; ++v) *(LAS unsigned short*)(F.lds + (16 * tt + 4 * q + v) * TROW + colb) = (unsigned short)(pk2(acc[v], 0.f) & 0xffffu);
            }
        }
    }
    __syncthreads();
    {
        bf16* Y = (bf16*)(F.ws + WS_Y);
        const float* gain = F.in[I_ONA] + oz;
        const f32x4 g0 = *(const f32x4*)(gain + 8 * F.lane), g1 = *(const f32x4*)(gain + 8 * F.lane + 4);
#pragma unroll 4
        for (int i = 0; i < 16; ++i) { const int t = 16 * F.wave + i;
            const v4u w = *(const LAS v4u*)(F.lds + t * TROW + 16 * F.lane); float f[8]; unpack8(w, f);
            const v4u uw = *(const v4u*)(UV + (size_t)(r0 + t) * 1024 + 8 * F.lane); float uf[8]; unpack8(uw, uf);
            float sq = 0.f;
#pragma unroll
            for (int j = 0; j < 8; ++j) { f[j] *= uf[j]; sq += f[j] * f[j]; }
            const float rstd = 1.0f / sqrtf(wave_sum(sq) * (1.0f / 512.0f) + EPS);
            float o[8];
#pragma unroll
            for (int j = 0; j < 4; ++j) { o[j] = f[j] * rstd * g0[j]; o[4 + j] = f[4 + j] * rstd * g1[j]; }
            *(v4u*)(Y + (size_t)(r0 + t) * 1024 + 8 * F.lane) = pack8f(o); }
    }
    __syncthreads();
}

__device__ __forceinline__ void mixer_b_unit(Frame& F, int ci) {
    const int r0 = 128 * ci, bs_row = (ci >> 6) * SEQ; const int oz = opaque_zero();
    const bf16* Gb = (const bf16*)(F.ws + WS_G) + oz;
    {
        const int cq = F.wave & 3, th = F.wave >> 2, c0 = 128 * cq + 2 * F.lane + oz;
        f32x2 wr_[31];
#pragma unroll
        for (int j = 0; j < 31; ++j) wr_[j] = *(const f32x2*)(F.in[I_CW] + j * 512 + c0);
        const f32x2 cb = *(const f32x2*)(F.in[I_CB] + c0), gg = *(const f32x2*)(F.in[I_GNG] + c0), gb = *(const f32x2*)(F.in[I_GNB] + c0);
        f32x2 win[38];
        const int base = r0 + 64 * th - 30;
#pragma unroll
        for (int i = 0; i < 38; ++i) { const int gr = base + i; unsigned w = 0u; if (gr >= bs_row) w = *(const unsigned*)(Gb + (size_t)gr * 512 + c0); win[i] = (f32x2){bflo(w), bfhi(w)}; }
#pragma unroll 1
        for (int blk = 0; blk < 8; ++blk) {
            unsigned nx[8];
            const int nb = blk < 7 ? blk + 1 : blk;
#pragma unroll
            for (int i = 0; i < 8; ++i) nx[i] = *(const unsigned*)(Gb + (size_t)(base + 8 * nb + 30 + i) * 512 + c0);
#pragma unroll
            for (int o = 0; o < 8; ++o) {
                f32x2 a = cb;
#pragma unroll
                for (int j = 0; j < 31; ++j) a += wr_[j] * win[o + j];
                const float mean = half_sum(a.x + a.y) * (1.0f / 64.0f);
                const float dx = a.x - mean, dy = a.y - mean;
                const float rstd = 1.0f / sqrtf(half_sum(dx * dx + dy * dy) * (1.0f / 64.0f) + EPS);
                const float yx = dx * rstd * gg.x + gb.x, yy = dy * rstd * gg.y + gb.y;
                const int t = 64 * th + 8 * blk + o;
                *(LAS unsigned*)(F.lds + t * TROW + 2 * (c0 - oz)) = pk2(siluf(yx), siluf(yy));
            }
#pragma unroll
            for (int i = 0; i < 30; ++i) win[i] = win[i + 8];
#pragma unroll
            for (int i = 0; i < 8; ++i) win[30 + i] = (f32x2){bflo(nx[i]), bfhi(nx[i])};
        }
    }
    __syncthreads();
    mixer_tail(F, r0, F.in[I_ONB] + oz, 512);
    __syncthreads();
}

__device__ __forceinline__ void p2_phase(Frame& F) {
    {
        const int gt = F.vcu * NTHR + F.tid, NT = F.G * NTHR;
        const float* PART = (const float*)(F.ws + WS_P2PART); float* B2 = (float*)(F.ws + WS_BIAS2);
        for (int e = gt; e < 2 * NFF; e += NT) { const int b = e / NFF, n = e % NFF; float s = 0.f;
#pragma unroll
            for (int kb = 0; kb < 16; ++kb) s += PART[(size_t)(kb * 2 + b) * NFF + n];
            B2[e] = s; }
    }
    #pragma unroll 1
    for (int uid = F.vcu; uid < 256; uid += F.G) {
        if (uid & 1) mixer_b_unit(F, uid >> 1); else mixer_a_unit(F, uid >> 1);
    }
}

__device__ __forceinline__ void p6_phase(Frame& F) {
    const float* COND = (const float*)(F.ws + WS_COND);
    const int gw = F.vcu * NWAVES + F.wave, NGW = F.G * NWAVES;
    for (int rb = gw; rb < M / 8; rb += NGW) {
        const int b = (rb * 8) >= SEQ ? 1 : 0;
        f32x4 av[4], sv[4];
#pragma unroll
        for (int j = 0; j < 4; ++j) { const int col = 4 * F.lane + 256 * j; const f32x4 g = *(const f32x4*)(F.in[I_NFG] + col), sc = *(const f32x4*)(COND + b * 8192 + 7168 + col); av[j] = g * (sc + 1.0f); sv[j] = *(const f32x4*)(COND + b * 8192 + 6144 + col); }
#pragma unroll 2
        for (int i = 0; i < 8; ++i) { const int row = rb * 8 + i; const f32x4* xr = (const f32x4*)((const float*)(F.ws + WS_X2) + (size_t)row * D) + F.lane; f32x4* xo = (f32x4*)(F.out + (size_t)row * D) + F.lane;
            f32x4 v[4]; float s = 0.f;
#pragma unroll
            for (int j = 0; j < 4; ++j) { v[j] = xr[64 * j]; s += (v[j][0] * v[j][0] + v[j][1] * v[j][1]) + (v[j][2] * v[j][2] + v[j][3] * v[j][3]); }
            const float rstd = 1.0f / sqrtf(wave_sum(s) * (1.0f / D) + EPS);
#pragma unroll
            for (int j = 0; j < 4; ++j) xo[64 * j] = v[j] * rstd * av[j] + sv[j]; }
    }
}

struct Args { const float* in[24]; float* out; unsigned char* ws; int ph_lo, ph_hi; };
__global__ void __launch_bounds__(NTHR, 2) mk_fwd(Args args) {
    extern __shared__ __attribute__((aligned(16))) unsigned char lds_raw[];
    cg::grid_group grid = cg::this_grid();
    Frame F;
    F.lds = (LAS unsigned char*)lds_raw;
    F.tid = threadIdx.x; F.lane = F.tid & 63; F.wave = __builtin_amdgcn_readfirstlane(F.tid >> 6);
    F.G = gridDim.x; { const int bx = blockIdx.x; F.vcu = (F.G % 8 == 0) ? (bx % 8) * (F.G / 8) + bx / 8 : bx; }
#pragma unroll
    for (int i = 0; i < 24; ++i) F.in[i] = args.in[i];
    F.out = args.out; F.ws = args.ws;
    const int lo = args.ph_lo, hi = args.ph_hi;
#define IN(k) (lo <= (k) && (k) < hi)
    const bool multi = (hi - lo) > 1;
    volatile LAS unsigned* MISC = (volatile LAS unsigned*)(F.lds + MISC_OFF);
    if (F.tid < 32) MISC[F.tid] = 0u;
    __syncthreads();
    XcdBarrier bar; bar.bar = (unsigned*)(F.ws + WS_CTL); bar.x = 0; bar.st = nullptr;
    if (multi) bar = xcd_barrier_post((unsigned*)(F.ws + WS_CTL), MISC + 8);
    if (lo < 0) grid.sync();
#define SEAM(k) do { if (IN(k) && IN((k) + 1)) xcd_barrier(bar); } while (0)
    const float* COND = (const float*)(F.ws + WS_COND);

    if (IN(0)) { p0_phase(F); if (MK_REP == 0) { __syncthreads(); p0_phase(F); } } SEAM(0);
    if (IN(1)) { p0b_phase(F); if (MK_REP == 1) { __syncthreads(); p0b_phase(F); } } SEAM(1);
    if (IN(2)) {
        pg8::Gemm g{(const pg8::bf16_t*)(F.ws + WS_XN), (const pg8::bf16_t*)(F.ws + WS_WIN), M, DIN, D, 0};
        pg8::StaticOrder S; S.init(M, DIN, F.G, (int)blockIdx.x);
        pg8::EpiP1 E{(pg8::bf16_t*)(F.ws + WS_UV), (pg8::bf16_t*)(F.ws + WS_G), (const float*)(F.ws + WS_BIAS1)};
        pg8::gemm_phase<pg8::EpiP1, pg8::StaticOrder, true, true>(F.lds, g, S, E);
        if (MK_REP == 2) { __syncthreads(); pg8::gemm_phase<pg8::EpiP1, pg8::StaticOrder, true, true>(F.lds, g, S, E); }
    } SEAM(2);
    if (IN(3)) { p2_phase(F); if (MK_REP == 3) { __syncthreads(); p2_phase(F); } } SEAM(3);
    if (IN(4)) {
        pg8::Gemm g{(const pg8::bf16_t*)(F.ws + WS_Y), (const pg8::bf16_t*)(F.ws + WS_WOUT), M, D, D, 0};
        pg8::StaticOrder S; S.init(M, D, F.G, (int)blockIdx.x);
        pg8::EpiRes<true> E{F.in[I_X], nullptr, COND + 2048, (pg8::bf16_t*)(F.ws + WS_XN), (float*)(F.ws + WS_SSQ1)};
        pg8::gemm_phase<pg8::EpiRes<true>, pg8::StaticOrder, true, true>(F.lds, g, S, E);
        if (MK_REP == 4) { __syncthreads(); pg8::gemm_phase<pg8::EpiRes<true>, pg8::StaticOrder, true, true>(F.lds, g, S, E); }
    } SEAM(4);
    if (IN(5)) {
        pg8::Gemm g{(const pg8::bf16_t*)(F.ws + WS_XN), (const pg8::bf16_t*)(F.ws + WS_WF1), M, NFF, D, (size_t)NFF * D * 2};
        pg8::StaticOrder S; S.init(M, NFF, F.G, (int)blockIdx.x);
        pg8::EpiP4 E{(pg8::bf16_t*)(F.ws + WS_H), (const float*)(F.ws + WS_BIAS2), (const float*)(F.ws + WS_SSQ1)};
        pg8::gemm_phase<pg8::EpiP4, pg8::StaticOrder, true, true>(F.lds, g, S, E);
        if (MK_REP == 5) { __syncthreads(); pg8::gemm_phase<pg8::EpiP4, pg8::StaticOrder, true, true>(F.lds, g, S, E); }
    } SEAM(5);
    if (IN(6)) {
        pg8::Gemm g{(const pg8::bf16_t*)(F.ws + WS_H), (const pg8::bf16_t*)(F.ws + WS_WF2), M, D, DFF, 0};
        pg8::StaticOrder S; S.init(M, D, F.G, (int)blockIdx.x);
        pg8::EpiRes<false> E{nullptr, (float*)(F.ws + WS_X2), COND + 5120, (pg8::bf16_t*)(F.ws + WS_XN), nullptr};
        pg8::gemm_phase<pg8::EpiRes<false>, pg8::StaticOrder, true, true>(F.lds, g, S, E);
        if (MK_REP == 6) { __syncthreads(); pg8::gemm_phase<pg8::EpiRes<false>, pg8::StaticOrder, true, true>(F.lds, g, S, E); }
    } SEAM(6);
    if (MK_REP == 8) { for (int q = 0; q < 10; ++q) xcd_barrier(bar); }
    if (IN(7)) { p6_phase(F); if (MK_REP == 7) { __syncthreads(); p6_phase(F); } }
#undef IN
#undef SEAM
}

extern "C" void kernel_launch(void* const* d_in, const int* in_sizes, int n_in, void* d_out, int out_size, void* d_ws, size_t ws_size, hipStream_t stream) {
    static int grid = 0;
    if (grid == 0) {
        if (n_in != 24 || in_sizes[0] != M * D || out_size != M * D || ws_size < WS_END) { fprintf(stderr, "kernel_launch: unexpected shapes (n_in %d, in0 %d, out %d, ws %zu)\n", n_in, n_in > 0 ? in_sizes[0] : -1, out_size, ws_size); grid = -1; return; }
        int dev = 0, cus = 0, per_cu = 0;
        (void)hipGetDevice(&dev); (void)hipDeviceGetAttribute(&cus, hipDeviceAttributeMultiprocessorCount, dev);
        if (hipFuncSetAttribute((const void*)mk_fwd, hipFuncAttributeMaxDynamicSharedMemorySize, LDS_BYTES) != hipSuccess) { fprintf(stderr, "kernel_launch: hipFuncSetAttribute failed\n"); grid = -1; return; }
        if (hipOccupancyMaxActiveBlocksPerMultiprocessor(&per_cu, (const void*)mk_fwd, NTHR, LDS_BYTES) != hipSuccess || per_cu < 1) { fprintf(stderr, "kernel_launch: occupancy query gave %d\n", per_cu); per_cu = 1; }
        (void)hipGetLastError();
        if (cus <= 0) cus = 256;
        grid = cus * per_cu;
        fprintf(stderr, "kernel_launch: %d CUs x %d = grid %d\n", cus, per_cu, grid);
    }
    if (grid < 0) return;
    Args a{};
    for (int i = 0; i < 24; ++i) a.in[i] = (const float*)d_in[i];
    a.out = (float*)d_out; a.ws = (unsigned char*)d_ws;
#if MK_N_LAUNCHES == 1
    if (hipMemsetAsync((char*)d_ws + WS_CTL, 0, CTL_ZERO_BYTES, stream) != hipSuccess) { fprintf(stderr, "kernel_launch: memset failed\n"); return; }
    a.ph_lo = 0; a.ph_hi = NPH;
    void* params[] = {&a};
    const hipError_t le = hipLaunchCooperativeKernel((const void*)mk_fwd, dim3(grid), dim3(NTHR), params, LDS_BYTES, stream);
    if (le != hipSuccess) fprintf(stderr, "kernel_launch: cooperative launch failed: %s (grid %d)\n", hipGetErrorName(le), grid);
#else
    for (int p = 0; p < NPH; ++p) {
        a.ph_lo = p; a.ph_hi = p + 1;
        hipLaunchKernelGGL(mk_fwd, dim3(grid), dim3(NTHR), LDS_BYTES, stream, a);
    }
#endif
}
```
